# Optimizing an MI355X kernel written in HIP

```python
import jax, jax.numpy as jnp
from jax import lax
import numpy as np

D_MODEL = 1024
BATCH = 1
SEQ = 16384
DEPTH = 4

HEAD_DIM = 64
ROPE_THETA = 10000.0
LN_EPS = 1e-5
NEG_INF = -1e30
Q_BLOCK = 128

NSA_HEADS = 8
NSA_GROUPS = 2
NSA_HPG = NSA_HEADS // NSA_GROUPS
NSA_Q_W = NSA_HEADS * HEAD_DIM
NSA_KV_W = NSA_GROUPS * HEAD_DIM
CMP_LEN = 32
CMP_STRIDE = 16
CMP_HIDDEN = 128
SLC_BLOCK = 64
SLC_RATIO = SLC_BLOCK // CMP_STRIDE
SLC_TOPK = 16
NSA_WINDOW = 512
FORCE_SCORE = 1e6

DIL_PAIRS = ((128, 1), (512, 4), (2048, 16))
DIL_HPG = 4
DIL_HEADS = DIL_HPG * 3
DIL_W = DIL_HEADS * HEAD_DIM
DIL_OUT_W = DIL_HPG * HEAD_DIM

SGU_CHUNK = 128
SGU_GROUPS = 4
SGU_GROUP_CH = 128
SGU_WIDTH = SGU_GROUPS * SGU_GROUP_CH

FFN_DIM = 2816

N_BRANCH = 3
IN_COLS = NSA_Q_W + 6 * NSA_KV_W + N_BRANCH * NSA_HEADS + 3 * DIL_W + 2 * SGU_WIDTH + N_BRANCH * D_MODEL

DEEPNORM_ALPHA = (2 * DEPTH) ** 0.25
DEEPNORM_BETA = (8 * DEPTH) ** -0.25

kernel_name = 'hybrid_nsa_dilated_sgu_macaron_deepnorm'


def layer_norm(x, g, b):
    xf = x.astype(jnp.float32)
    mu = jnp.mean(xf, axis=-1, keepdims=True)
    var = jnp.mean(jnp.square(xf - mu), axis=-1, keepdims=True)
    return ((xf - mu) * lax.rsqrt(var + LN_EPS) * g + b).astype(x.dtype)


def swiglu(x, w_gate, w_up, w_down):
    return (jax.nn.silu(x @ w_gate) * (x @ w_up)) @ w_down


def rope_tables(seq):
    inv = 1.0 / (ROPE_THETA ** (jnp.arange(0, HEAD_DIM, 2, dtype=jnp.float32) / HEAD_DIM))
    ang = jnp.arange(seq, dtype=jnp.float32)[:, None] * inv[None, :]
    return jnp.cos(ang), jnp.sin(ang)


def apply_rope(x, cos, sin):
    half = HEAD_DIM // 2
    shape = (1, x.shape[1]) + (1,) * (x.ndim - 3) + (half,)
    c = cos.reshape(shape).astype(x.dtype)
    s = sin.reshape(shape).astype(x.dtype)
    x1, x2 = x[..., :half], x[..., half:]
    return jnp.concatenate([x1 * c - x2 * s, x2 * c + x1 * s], axis=-1)


def masked_softmax(scores, mask):
    s = jnp.where(mask, scores.astype(jnp.float32), NEG_INF)
    m = jnp.max(s, axis=-1, keepdims=True)
    e = jnp.exp(s - m) * mask
    den = jnp.sum(e, axis=-1, keepdims=True)
    p = e / jnp.maximum(den, 1e-30)
    lse = m[..., 0] + jnp.log(jnp.maximum(den[..., 0], 1e-30))
    return p, lse


def compress_blocks(x, pos, w1, w2):
    B, S, G, Dh = x.shape
    n_cmp = S // CMP_STRIDE
    xp = jnp.pad(x, ((0, 0), (0, CMP_STRIDE), (0, 0), (0, 0)))
    sub = xp.reshape(B, n_cmp + 1, CMP_STRIDE, G, Dh)
    blk = jnp.concatenate([sub[:, :-1], sub[:, 1:]], axis=2) + pos[None, None, :, None, :]
    flat = blk.transpose(0, 1, 3, 2, 4).reshape(B, n_cmp, G, CMP_LEN * Dh)
    return jax.nn.gelu(flat @ w1) @ w2


def nsa_mixer(q, k_c, v_c, k_s, v_s, k_w, v_w, gate, pk_pos, pk_w1, pk_w2, pv_pos, pv_w1, pv_w2, cos, sin):
    B, S = q.shape[:2]
    G, HPG, Dh = NSA_GROUPS, NSA_HPG, HEAD_DIM
    scale = Dh ** -0.5
    n_cmp = S // CMP_STRIDE
    n_slc = S // SLC_BLOCK
    n_blk = S // Q_BLOCK
    top_k = min(SLC_TOPK, n_slc)
    q = q.reshape(B, S, G, HPG, Dh)
    q_rot = apply_rope(q, cos, sin)
    k_s = apply_rope(k_s, cos, sin)
    k_w = apply_rope(k_w, cos, sin)
    kc = compress_blocks(k_c, pk_pos, pk_w1, pk_w2)
    vc = compress_blocks(v_c, pv_pos, pv_w1, pv_w2)
    c_end = jnp.arange(n_cmp) * CMP_STRIDE + (CMP_LEN - 1)
    ks_b = k_s.reshape(B, n_slc, SLC_BLOCK, G, Dh).transpose(0, 3, 1, 2, 4)
    vs_b = v_s.reshape(B, n_slc, SLC_BLOCK, G, Dh).transpose(0, 3, 1, 2, 4)
    kw_p = jnp.pad(k_w, ((0, 0), (NSA_WINDOW, 0), (0, 0), (0, 0)))
    vw_p = jnp.pad(v_w, ((0, 0), (NSA_WINDOW, 0), (0, 0), (0, 0)))
    slc_idx = jnp.arange(n_slc)
    bi = jnp.arange(B)[:, None, None, None]
    gi = jnp.arange(G)[None, :, None, None]

    def block_fn(args):
        blk, qr, qp = args
        t = blk * Q_BLOCK + jnp.arange(Q_BLOCK)
        s_c = jnp.einsum('bqghd,bngd->bghqn', qr, kc) * scale
        p_c, _ = masked_softmax(s_c, c_end[None, :] <= t[:, None])
        o_c = jnp.einsum('bghqn,bngd->bqghd', p_c.astype(vc.dtype), vc)
        imp = jnp.pad(jnp.sum(p_c, axis=2), ((0, 0), (0, 0), (0, 0), (1, SLC_RATIO - 1)))
        p_slc = imp[..., :n_cmp].reshape(B, G, Q_BLOCK, n_slc, SLC_RATIO).sum(-1) + imp[..., SLC_RATIO::SLC_RATIO]
        cur = (t // SLC_BLOCK)[:, None]
        forced = (slc_idx[None] == 0) | (slc_idx[None] == cur) | (slc_idx[None] == cur - 1)
        future = slc_idx[None] * SLC_BLOCK > t[:, None]
        sel_score = jnp.where(forced, FORCE_SCORE, jnp.where(future, -1.0, p_slc))
        _, idx = lax.top_k(sel_score, top_k)
        kg = ks_b[bi, gi, idx].reshape(B, G, Q_BLOCK, top_k * SLC_BLOCK, Dh)
        vg = vs_b[bi, gi, idx].reshape(B, G, Q_BLOCK, top_k * SLC_BLOCK, Dh)
        kpos = (idx[..., None] * SLC_BLOCK + jnp.arange(SLC_BLOCK)).reshape(B, G, Q_BLOCK, top_k * SLC_BLOCK)
        s_s = jnp.einsum('bqghd,bgqkd->bghqk', qp, kg) * scale
        p_s, _ = masked_softmax(s_s, (kpos <= t[None, None, :, None])[:, :, None])
        o_s = jnp.einsum('bghqk,bgqkd->bqghd', p_s.astype(vg.dtype), vg)
        kw = lax.dynamic_slice_in_dim(kw_p, blk * Q_BLOCK, Q_BLOCK + NSA_WINDOW, axis=1)
        vw = lax.dynamic_slice_in_dim(vw_p, blk * Q_BLOCK, Q_BLOCK + NSA_WINDOW, axis=1)
        kpos_w = blk * Q_BLOCK - NSA_WINDOW + jnp.arange(Q_BLOCK + NSA_WINDOW)
        diff = t[:, None] - kpos_w[None, :]
        m_w = (diff >= 0) & (diff < NSA_WINDOW) & (kpos_w[None, :] >= 0)
        s_w = jnp.einsum('bqghd,bkgd->bghqk', qp, kw) * scale
        p_w, _ = masked_softmax(s_w, m_w)
        o_w = jnp.einsum('bghqk,bkgd->bqghd', p_w.astype(vw.dtype), vw)
        return o_c, o_s, o_w

    def to_blocks(x):
        return jnp.moveaxis(x.reshape(B, n_blk, Q_BLOCK, G, HPG, Dh), 1, 0)

    o_c, o_s, o_w = lax.map(block_fn, (jnp.arange(n_blk), to_blocks(q), to_blocks(q_rot)))
    back = lambda o: jnp.moveaxis(o, 0, 1).reshape(B, S, G, HPG, Dh)
    g = jax.nn.sigmoid(gate.reshape(B, S, G, HPG, N_BRANCH))[..., None]
    o = g[..., 0, :] * back(o_c) + g[..., 1, :] * back(o_s) + g[..., 2, :] * back(o_w)
    return o.reshape(B, S, NSA_Q_W)


def dilated_group(q, k, v, span, dil):
    B, S, Hg, Dh = q.shape
    unit = dil * Q_BLOCK
    s_pad = -(-S // unit) * unit
    m_len = s_pad // dil
    n_sub = m_len // Q_BLOCK

    def to_sub(x):
        x = jnp.pad(x, ((0, 0), (0, s_pad - S), (0, 0), (0, 0)))
        x = x.reshape(B, m_len, dil, Hg, Dh).transpose(0, 2, 1, 3, 4)
        return x.reshape(B, dil, n_sub, Q_BLOCK, Hg, Dh)

    def with_prev(x):
        prev = jnp.pad(x, ((0, 0), (0, 0), (1, 0), (0, 0), (0, 0), (0, 0)))[:, :, :-1]
        return jnp.concatenate([prev, x], axis=3)

    qs = to_sub(q)
    ks = with_prev(to_sub(k))
    vs = with_prev(to_sub(v))
    scores = jnp.einsum('brnqhd,brnkhd->brnhqk', qs, ks) * (Dh ** -0.5)
    qi = jnp.arange(Q_BLOCK)[:, None] + Q_BLOCK
    ki = jnp.arange(2 * Q_BLOCK)[None, :]
    delta = qi - ki
    band = (delta >= 0) & (delta <= span)
    first = (jnp.arange(n_sub) == 0)[:, None, None] & (ki < Q_BLOCK)[None]
    mask = (band[None] & ~first)[:, None]
    p, lse = masked_softmax(scores, mask)
    o = jnp.einsum('brnhqk,brnkhd->brnqhd', p.astype(vs.dtype), vs)
    o = o.reshape(B, dil, m_len, Hg, Dh).transpose(0, 2, 1, 3, 4).reshape(B, s_pad, Hg, Dh)[:, :S]
    lse = lse.transpose(0, 1, 2, 4, 3).reshape(B, dil, m_len, Hg).transpose(0, 2, 1, 3).reshape(B, s_pad, Hg)[:, :S]
    return o, lse


def dilated_mixer(q, k, v, cos, sin):
    B, S = q.shape[:2]
    q = apply_rope(q.reshape(B, S, DIL_HEADS, HEAD_DIM), cos, sin)
    k = apply_rope(k.reshape(B, S, DIL_HEADS, HEAD_DIM), cos, sin)
    v = v.reshape(B, S, DIL_HEADS, HEAD_DIM)
    outs, lses = [], []
    for gidx, (win, dil) in enumerate(DIL_PAIRS):
        hs = slice(gidx * DIL_HPG, (gidx + 1) * DIL_HPG)
        o, lse = dilated_group(q[:, :, hs], k[:, :, hs], v[:, :, hs], win // dil, dil)
        outs.append(o)
        lses.append(lse)
    w = jax.nn.softmax(jnp.stack(lses, axis=0), axis=0)
    o = jnp.sum(w[..., None].astype(v.dtype) * jnp.stack(outs, axis=0), axis=0)
    return o.reshape(B, S, DIL_OUT_W)


def sgu_mixer(uv, ln_g, ln_b, w_s, b_s):
    B, S, _ = uv.shape
    uv = jax.nn.gelu(uv)
    u, v = uv[..., :SGU_WIDTH], uv[..., SGU_WIDTH:]
    v = layer_norm(v, ln_g, ln_b)
    vc = v.reshape(B, S // SGU_CHUNK, SGU_CHUNK, SGU_GROUPS, SGU_GROUP_CH)
    causal = jnp.tril(jnp.ones((SGU_CHUNK, SGU_CHUNK), dtype=bool))
    ws = jnp.where(causal[None], w_s, 0)
    sv = jnp.einsum('gts,bnsgc->bntgc', ws, vc) + b_s.T[None, None, :, :, None]
    return u * sv.reshape(B, S, SGU_WIDTH)


def token_mixing(h, w_in, pk_pos, pk_w1, pk_w2, pv_pos, pv_w1, pv_w2, sgu_ln_g, sgu_ln_b, sgu_w, sgu_b,
                 w_branch_a, w_branch_b, w_branch_c, w_out, cos, sin):
    sizes = [NSA_Q_W] + [NSA_KV_W] * 6 + [N_BRANCH * NSA_HEADS, DIL_W, DIL_W, DIL_W, 2 * SGU_WIDTH, N_BRANCH * D_MODEL]
    z = h @ w_in
    parts = jnp.split(z, np.cumsum(sizes)[:-1].tolist(), axis=-1)
    q_a, kc, vc, ks, vs, kw, vw, g_a, q_b, k_b, v_b, uv, g_m = parts
    B, S, _ = h.shape
    kv = lambda t: t.reshape(B, S, NSA_GROUPS, HEAD_DIM)
    y_a = nsa_mixer(q_a, kv(kc), kv(vc), kv(ks), kv(vs), kv(kw), kv(vw), g_a,
                    pk_pos, pk_w1, pk_w2, pv_pos, pv_w1, pv_w2, cos, sin) @ w_branch_a
    y_b = dilated_mixer(q_b, k_b, v_b, cos, sin) @ w_branch_b
    y_c = sgu_mixer(uv, sgu_ln_g, sgu_ln_b, sgu_w, sgu_b) @ w_branch_c
    g = jax.nn.sigmoid(g_m)
    merged = g[..., :D_MODEL] * y_a + g[..., D_MODEL:2 * D_MODEL] * y_b + g[..., 2 * D_MODEL:] * y_c
    return merged @ w_out


def setup_inputs(seed: int = 0) -> dict:
    key = jax.random.key(seed)
    ks = jax.random.split(key, 24)
    L, D = DEPTH, D_MODEL

    def nrm(k, shape, scale):
        return jax.random.normal(k, shape, jnp.float32) * scale

    return {
        'x': nrm(ks[0], (BATCH, SEQ, D), 1.0),
        'ln_g': 1.0 + nrm(ks[1], (L, 3, D), 0.02),
        'ln_b': nrm(ks[2], (L, 3, D), 0.02),
        'ffn1_gate': nrm(ks[3], (L, D, FFN_DIM), D ** -0.5),
        'ffn1_up': nrm(ks[4], (L, D, FFN_DIM), D ** -0.5),
        'ffn1_down': nrm(ks[5], (L, FFN_DIM, D), FFN_DIM ** -0.5 * DEEPNORM_BETA),
        'ffn2_gate': nrm(ks[6], (L, D, FFN_DIM), D ** -0.5),
        'ffn2_up': nrm(ks[7], (L, D, FFN_DIM), D ** -0.5),
        'ffn2_down': nrm(ks[8], (L, FFN_DIM, D), FFN_DIM ** -0.5 * DEEPNORM_BETA),
        'w_in': nrm(ks[9], (L, D, IN_COLS), D ** -0.5),
        'phi_k_pos': nrm(ks[10], (L, CMP_LEN, HEAD_DIM), 0.5),
        'phi_k_w1': nrm(ks[11], (L, CMP_LEN * HEAD_DIM, CMP_HIDDEN), (CMP_LEN * HEAD_DIM) ** -0.5),
        'phi_k_w2': nrm(ks[12], (L, CMP_HIDDEN, HEAD_DIM), CMP_HIDDEN ** -0.5),
        'phi_v_pos': nrm(ks[13], (L, CMP_LEN, HEAD_DIM), 0.5),
        'phi_v_w1': nrm(ks[14], (L, CMP_LEN * HEAD_DIM, CMP_HIDDEN), (CMP_LEN * HEAD_DIM) ** -0.5),
        'phi_v_w2': nrm(ks[15], (L, CMP_HIDDEN, HEAD_DIM), CMP_HIDDEN ** -0.5),
        'sgu_ln_g': 1.0 + nrm(ks[16], (L, SGU_WIDTH), 0.02),
        'sgu_ln_b': nrm(ks[17], (L, SGU_WIDTH), 0.02),
        'sgu_w': nrm(ks[18], (L, SGU_GROUPS, SGU_CHUNK, SGU_CHUNK), 0.5 * SGU_CHUNK ** -0.5),
        'sgu_b': 1.0 + nrm(ks[19], (L, SGU_GROUPS, SGU_CHUNK), 0.02),
        'w_branch_a': nrm(ks[20], (L, NSA_Q_W, D), NSA_Q_W ** -0.5),
        'w_branch_b': nrm(ks[21], (L, DIL_OUT_W, D), DIL_OUT_W ** -0.5),
        'w_branch_c': nrm(ks[22], (L, SGU_WIDTH, D), SGU_WIDTH ** -0.5),
        'w_out': nrm(ks[23], (L, D, D), D ** -0.5 * DEEPNORM_BETA),
    }


def reference(x, ln_g, ln_b, ffn1_gate, ffn1_up, ffn1_down, ffn2_gate, ffn2_up, ffn2_down, w_in,
              phi_k_pos, phi_k_w1, phi_k_w2, phi_v_pos, phi_v_w1, phi_v_w2,
              sgu_ln_g, sgu_ln_b, sgu_w, sgu_b, w_branch_a, w_branch_b, w_branch_c, w_out):
    cos, sin = rope_tables(x.shape[1])
    for l in range(DEPTH):
        x = layer_norm(DEEPNORM_ALPHA * x + 0.5 * swiglu(x, ffn1_gate[l], ffn1_up[l], ffn1_down[l]),
                       ln_g[l, 0], ln_b[l, 0])
        mix = token_mixing(x, w_in[l], phi_k_pos[l], phi_k_w1[l], phi_k_w2[l], phi_v_pos[l], phi_v_w1[l], phi_v_w2[l],
                           sgu_ln_g[l], sgu_ln_b[l], sgu_w[l], sgu_b[l],
                           w_branch_a[l], w_branch_b[l], w_branch_c[l], w_out[l], cos, sin)
        x = layer_norm(DEEPNORM_ALPHA * x + mix, ln_g[l, 1], ln_b[l, 1])
        x = layer_norm(DEEPNORM_ALPHA * x + 0.5 * swiglu(x, ffn2_gate[l], ffn2_up[l], ffn2_down[l]),
                       ln_g[l, 2], ln_b[l, 2])
    return x
```

```cpp
#include <hip/hip_runtime.h>
#include <hip/hip_cooperative_groups.h>
#include <cstdio>
#include <cstdint>
#include <cmath>
namespace cg = cooperative_groups;
namespace pg8 {
#define PG8_LAS __attribute__((address_space(3)))
typedef unsigned short bf16_t;
typedef short bf16x8 __attribute__((ext_vector_type(8)));
typedef float f32x4 __attribute__((ext_vector_type(4)));
typedef unsigned u32x4 __attribute__((ext_vector_type(4)));
constexpr int BM = 256, BK = 64, HALF = 128, HTB = HALF * BK * 2  , STAGE_BYTES = 8 * HTB, NXCD = 8, WGM = 8;

__host__ __device__ __forceinline__ int lds_byte(int r, int c) { const int st = (r >> 4) * 2 + (c >> 5), rr = r & 15, cc = c & 31, ob = rr * 64 + cc * 2; return st * 1024 + (ob ^ (((ob >> 9) & 1) << 5)); }
__host__ __device__ __forceinline__ void stage_rc(int b, int& R, int& C) { const int st = b / 1024, sb = b % 1024, swz = sb ^ (((sb >> 9) & 1) << 5); R = (st >> 1) * 16 + swz / 64; C = (st & 1) * 32 + (swz % 64) / 2; }
__host__ __device__ __forceinline__ int perm32(int rho) { const int n = rho >> 4, i = rho & 15; return 8 * (i >> 2) + 4 * n + (i & 3); }

struct Unit { int pm, pn; };
struct Gemm { const bf16_t* A; const bf16_t* Bt; int M, N, K; };

struct StaticOrder {
    int nM, nN, nwg, G, c;
    __host__ __device__ void init(int M, int N, int G_, int c_) { nM = M / BM; nN = N / BM; nwg = nM * nN; G = G_; c = c_; }
    __host__ __device__ bool next(int i, Unit& u) const {
        const long L = (long)i * G + c; if (L >= nwg) return false;
        int wgid = (int)L; { const int q = nwg / NXCD, r = nwg % NXCD, xcd = wgid % NXCD, off = wgid / NXCD; wgid = (xcd < r ? xcd * (q + 1) : r * (q + 1) + (xcd - r) * q) + off; }
        const int nig = WGM * nN, gid = wgid / nig, fm = gid * WGM, gsz = (nM - fm) < WGM ? (nM - fm) : WGM;
        u.pm = fm + ((wgid % nig) % gsz); u.pn = (wgid % nig) / gsz; return true;
    }
    __device__ __forceinline__ void a_ready(const Unit&) const {}
    __device__ __forceinline__ void done(const Unit&) const {}
};

__device__ __forceinline__ unsigned cvt_pk_bf16(float lo, float hi) { unsigned r; asm volatile("v_cvt_pk_bf16_f32 %0, %1, %2" : "=v"(r) : "v"(lo), "v"(hi)); return r; }
typedef float f32x2 __attribute__((ext_vector_type(2)));
__device__ __forceinline__ f32x2 gelu_pk(f32x2 v) {
    const f32x2 av = __builtin_elementwise_abs(v), d = av * 0.2316418882f + 1.0f;
    f32x2 t; t.x = __builtin_amdgcn_rcpf(d.x); t.y = __builtin_amdgcn_rcpf(d.y);
    f32x2 q = t * 0.5307027145f + (-0.7265760135f); q = q * t + 0.7107068705f; q = q * t + (-0.142248368f); q = q * t + 0.127414796f; q = q * t;
    const f32x2 s = (v * v) * (-0.72134752044f);
    f32x2 e; e.x = __builtin_amdgcn_exp2f(s.x); e.y = __builtin_amdgcn_exp2f(s.y);
    const f32x2 m = v * (q * e), r = v - m;
    f32x2 o; o.x = v.x < 0.f ? m.x : r.x; o.y = v.y < 0.f ? m.y : r.y; return o;
}

template <int ACT  > struct EpiBf16 {
    static constexpr bool PERM = true, AFTER_DRAIN = false; static_assert(ACT == 0 || ACT == 1, "EpiBf16: ACT is 0 (none) or 1 (gelu_pk)");
    bf16_t* O; int ldc; const float* bias; int split_cols; size_t split_stride; float scale0;
    __device__ __forceinline__ void operator()(const f32x4 (&acc)[2][2][4][2], const Unit& u, int wr, int wc, int fr, int fq) const {
        const int row0 = u.pm * BM + wr * 64 + fr; int colt = u.pn * BM; bf16_t* base = O;
        float sc = 1.f; if (split_cols) { const int t = colt / split_cols; base += (size_t)t * split_stride; colt -= t * split_cols; if (t == 0) sc = scale0; }
        const int col0 = colt + wc * 32 + 8 * fq, bcol0 = u.pn * BM + wc * 32 + 8 * fq;
        f32x4 bv[2][2];
#pragma unroll
        for (int bj = 0; bj < 2; ++bj)
#pragma unroll
            for (int n = 0; n < 2; ++n) bv[bj][n] = bias ? *(const f32x4*)(bias + bcol0 + bj * HALF + 4 * n) : (f32x4){0.f, 0.f, 0.f, 0.f};
#pragma unroll
        for (int ai = 0; ai < 2; ++ai)
#pragma unroll
            for (int m = 0; m < 4; ++m) { bf16_t* rowp = base + (size_t)(row0 + ai * HALF + m * 16) * ldc + col0;
#pragma unroll
                for (int bj = 0; bj < 2; ++bj) { f32x4 v0 = acc[ai][bj][m][0] + bv[bj][0], v1 = acc[ai][bj][m][1] + bv[bj][1];
                    if (ACT == 1) { f32x2 a = gelu_pk((f32x2){v0[0], v0[1]}), b = gelu_pk((f32x2){v0[2], v0[3]}), c = gelu_pk((f32x2){v1[0], v1[1]}), d = gelu_pk((f32x2){v1[2], v1[3]});
                        v0 = (f32x4){a.x, a.y, b.x, b.y}; v1 = (f32x4){c.x, c.y, d.x, d.y}; }
                    v0 = v0 * sc; v1 = v1 * sc; u32x4 w; w.x = cvt_pk_bf16(v0[0], v0[1]); w.y = cvt_pk_bf16(v0[2], v0[3]); w.z = cvt_pk_bf16(v1[0], v1[1]); w.w = cvt_pk_bf16(v1[2], v1[3]);
                    *(u32x4*)(rowp + bj * HALF) = w; } }
    }
};


template <class Epi, class Sched, bool ALIGN_EPI = false, bool SP2 = false>
__device__ __forceinline__ void gemm_phase(PG8_LAS unsigned char* lds, const Gemm g, const Sched& S, const Epi& E) {
    int tid_ = threadIdx.x; asm volatile("" : "+v"(tid_)); const int tid = tid_, wid = __builtin_amdgcn_readfirstlane(tid >> 6), lane = tid & 63, wr = wid >> 2, wc = wid & 3, fr = lane & 15, fq = lane >> 4;
    const int K = g.K, nt = K / BK;
    unsigned voffA[2], voffB[2];
#pragma unroll
    for (int i = 0; i < 2; ++i) { int R, C; stage_rc(tid * 16 + i * 8192, R, C); const int Rb = Epi::PERM ? ((R & ~31) + perm32(R & 31)) : R;
        voffA[i] = (unsigned)(R * K + C) * 2u; voffB[i] = (unsigned)(Rb * K + C) * 2u; }
    const size_t kstep = (size_t)(BK * 2);
    const size_t hstep = (size_t)HALF * K * 2;
    const size_t tstep = 2 * hstep;
    const unsigned ldsw = (unsigned)wid * 1024u;
    const int aoff = lds_byte(wr * 64 + fr, fq * 8), boff = lds_byte(wc * 32 + fr, fq * 8);
#define PG8_SA(b, h) (((b) * 2 + (h)) * HTB)
#define PG8_SB(b, h) ((4 + (b) * 2 + (h)) * HTB)
#define PG8_STAGE(bufoff, gbase, voff) do { _Pragma("unroll") for (int _i = 0; _i < 2; ++_i) \
        __builtin_amdgcn_global_load_lds((const unsigned*)((const char*)(gbase) + (voff)[_i]), (PG8_LAS unsigned*)(lds + (bufoff) + ldsw + _i * 8192), 16, 0, 0); } while (0)
#define PG8_LDA(dst, b, h) do { _Pragma("unroll") for (int m = 0; m < 4; ++m) _Pragma("unroll") for (int k = 0; k < 2; ++k) dst[m][k] = *(const PG8_LAS bf16x8*)(lds + PG8_SA(b, h) + aoff + m * 2048 + k * 1024); } while (0)
#define PG8_LDB(dst, b, h) do { _Pragma("unroll") for (int n = 0; n < 2; ++n) _Pragma("unroll") for (int k = 0; k < 2; ++k) dst[n][k] = *(const PG8_LAS bf16x8*)(lds + PG8_SB(b, h) + boff + n * 2048 + k * 1024); } while (0)
#define PG8_MMA(ai, bj, At, Bt) do { __builtin_amdgcn_s_setprio(1); _Pragma("unroll") for (int m = 0; m < 4; ++m) _Pragma("unroll") for (int n = 0; n < 2; ++n) _Pragma("unroll") for (int k = 0; k < 2; ++k) \
        acc[ai][bj][m][n] = __builtin_amdgcn_mfma_f32_16x16x32_bf16(Bt[n][k], At[m][k], acc[ai][bj][m][n], 0, 0, 0); __builtin_amdgcn_s_setprio(0); } while (0)
#define PG8_WAIT_V(n) asm volatile("s_waitcnt vmcnt(" #n ")" ::: "memory")
#define PG8_WAIT_L(n) asm volatile("s_waitcnt lgkmcnt(" #n ")" ::: "memory")
#define PG8_BAR __builtin_amdgcn_s_barrier()
#define PG8_SCHED __builtin_amdgcn_sched_barrier(0)
    Unit cur, nxt; int ui = 0;
    if (!S.next(0, cur)) return;
    f32x4 acc[2][2][4][2];
#pragma unroll
    for (int a = 0; a < 2; ++a)
#pragma unroll
        for (int b = 0; b < 2; ++b)
#pragma unroll
            for (int m = 0; m < 4; ++m)
#pragma unroll
                for (int n = 0; n < 2; ++n) acc[a][b][m][n] = (f32x4){0.f, 0.f, 0.f, 0.f};
    bf16x8 At[4][2], B0[2][2], B1[2][2];
    const char* cA = (const char*)g.A + (size_t)cur.pm * tstep; const char* cB = (const char*)g.Bt + (size_t)cur.pn * tstep;
    S.a_ready(cur);
    if constexpr (SP2) {
        PG8_STAGE(PG8_SB(0, 0), cB, voffB); PG8_STAGE(PG8_SB(0, 1), cB + hstep, voffB); PG8_STAGE(PG8_SA(0, 0), cA, voffA); PG8_STAGE(PG8_SA(0, 1), cA + hstep, voffA);
        if (wr == 1) PG8_BAR;
        PG8_WAIT_V(2); PG8_BAR;
        PG8_STAGE(PG8_SB(1, 0), cB + kstep, voffB); PG8_STAGE(PG8_SA(1, 0), cA + kstep, voffA); PG8_STAGE(PG8_SB(1, 1), cB + hstep + kstep, voffB);
        PG8_WAIT_V(6); PG8_BAR;
    } else {
        PG8_STAGE(PG8_SB(0, 0), cB, voffB); PG8_STAGE(PG8_SA(0, 0), cA, voffA); PG8_STAGE(PG8_SB(0, 1), cB + hstep, voffB); PG8_STAGE(PG8_SA(0, 1), cA + hstep, voffA);
        if (wr == 1) PG8_BAR;
        PG8_WAIT_V(4); PG8_BAR;
        PG8_STAGE(PG8_SB(1, 0), cB + kstep, voffB); PG8_STAGE(PG8_SA(1, 0), cA + kstep, voffA); PG8_STAGE(PG8_SB(1, 1), cB + hstep + kstep, voffB);
        PG8_WAIT_V(6); PG8_BAR;
    }
    for (;;) {
        const bool has_next = S.next(ui + 1, nxt);
        const char* nA = has_next ? (const char*)g.A + (size_t)nxt.pm * tstep : cA; const char* nB = has_next ? (const char*)g.Bt + (size_t)nxt.pn * tstep : cB;
        for (int t = 0; t < nt; t += 2) {
            const bool last = (t == nt - 2);
            const char* a1 = cA + (size_t)(t + 1) * kstep;
            const char* a2 = last ? nA : cA + (size_t)(t + 2) * kstep; const char* b2 = last ? nB : cB + (size_t)(t + 2) * kstep;
            const char* a3 = a2 + kstep; const char* b3 = b2 + kstep;
            if (last && has_next) S.a_ready(nxt);
            if constexpr (SP2) {
            PG8_LDB(B0, 0, 0); PG8_LDB(B1, 0, 1); PG8_SCHED; PG8_LDA(At, 0, 0); PG8_STAGE(PG8_SA(1, 1), a1 + hstep, voffA);
            PG8_WAIT_V(8); PG8_WAIT_L(0); PG8_BAR; PG8_MMA(0, 0, At, B0); PG8_MMA(0, 1, At, B1); PG8_BAR; PG8_SCHED;
            PG8_LDA(At, 0, 1); PG8_STAGE(PG8_SB(0, 0), b2, voffB); PG8_STAGE(PG8_SB(0, 1), b2 + hstep, voffB); PG8_STAGE(PG8_SA(0, 0), a2, voffA);
            PG8_WAIT_V(8); PG8_WAIT_L(0); PG8_BAR; PG8_MMA(1, 0, At, B0); PG8_MMA(1, 1, At, B1); PG8_BAR; PG8_SCHED;
            PG8_LDB(B0, 1, 0); PG8_LDB(B1, 1, 1); PG8_SCHED; PG8_LDA(At, 1, 0); PG8_STAGE(PG8_SA(0, 1), a2 + hstep, voffA);
            PG8_WAIT_V(8); PG8_WAIT_L(0); PG8_BAR; PG8_MMA(0, 0, At, B0); PG8_MMA(0, 1, At, B1); PG8_BAR; PG8_SCHED;
            PG8_LDA(At, 1, 1); PG8_STAGE(PG8_SB(1, 0), b3, voffB); PG8_STAGE(PG8_SB(1, 1), b3 + hstep, voffB); PG8_STAGE(PG8_SA(1, 0), a3, voffA);
            PG8_WAIT_V(8); PG8_WAIT_L(0); PG8_BAR; PG8_MMA(1, 0, At, B0); PG8_MMA(1, 1, At, B1); PG8_BAR; PG8_SCHED;
            } else {
            PG8_LDB(B0, 0, 0); PG8_SCHED; PG8_LDA(At, 0, 0); PG8_STAGE(PG8_SA(1, 1), a1 + hstep, voffA);
            PG8_WAIT_L(8); PG8_BAR; PG8_WAIT_L(0); PG8_MMA(0, 0, At, B0); PG8_BAR; PG8_SCHED;
            PG8_LDB(B1, 0, 1); PG8_STAGE(PG8_SB(0, 0), b2, voffB);
            PG8_BAR; PG8_WAIT_L(0); PG8_MMA(0, 1, At, B1); PG8_BAR;
            PG8_LDA(At, 0, 1); PG8_STAGE(PG8_SA(0, 0), a2, voffA);
            PG8_BAR; PG8_WAIT_L(0); PG8_MMA(1, 0, At, B0); PG8_BAR; PG8_SCHED;
            PG8_STAGE(PG8_SB(0, 1), b2 + hstep, voffB);
            PG8_WAIT_V(6); PG8_BAR; PG8_MMA(1, 1, At, B1); PG8_BAR;
            PG8_LDB(B0, 1, 0); PG8_SCHED; PG8_LDA(At, 1, 0); PG8_STAGE(PG8_SA(0, 1), a2 + hstep, voffA);
            PG8_WAIT_L(8); PG8_BAR; PG8_WAIT_L(0); PG8_MMA(0, 0, At, B0); PG8_BAR; PG8_SCHED;
            PG8_LDB(B1, 1, 1); PG8_STAGE(PG8_SB(1, 0), b3, voffB);
            PG8_BAR; PG8_WAIT_L(0); PG8_MMA(0, 1, At, B1); PG8_BAR;
            PG8_LDA(At, 1, 1); PG8_STAGE(PG8_SA(1, 0), a3, voffA);
            PG8_BAR; PG8_WAIT_L(0); PG8_MMA(1, 0, At, B0); PG8_BAR; PG8_SCHED;
            PG8_STAGE(PG8_SB(1, 1), b3 + hstep, voffB);
            PG8_WAIT_V(6); PG8_BAR; PG8_MMA(1, 1, At, B1); PG8_BAR;
            }
        }
        if constexpr (ALIGN_EPI) { if (wr == 0) PG8_BAR; }
        if constexpr (!Epi::AFTER_DRAIN) { E(acc, cur, wr, wc, fr, fq); S.done(cur); }
        if (!has_next) break;
#pragma unroll
        for (int a = 0; a < 2; ++a)
#pragma unroll
            for (int b = 0; b < 2; ++b)
#pragma unroll
                for (int m = 0; m < 4; ++m)
#pragma unroll
                    for (int n = 0; n < 2; ++n) acc[a][b][m][n] = (f32x4){0.f, 0.f, 0.f, 0.f};
        cur = nxt; cA = nA; cB = nB; ++ui;
        if constexpr (ALIGN_EPI) { if (wr == 1) PG8_BAR; }
    }
    PG8_WAIT_V(0);
    if constexpr (!ALIGN_EPI) { if (wr == 0) PG8_BAR; }
    PG8_BAR;
    if constexpr (Epi::AFTER_DRAIN) { E.fused(acc, cur, wr, wc, fr, fq, lds, wid, lane); S.done(cur); }
#undef PG8_SA
#undef PG8_SB
#undef PG8_STAGE
#undef PG8_LDA
#undef PG8_LDB
#undef PG8_MMA
#undef PG8_WAIT_V
#undef PG8_WAIT_L
#undef PG8_BAR
#undef PG8_SCHED
}
}

#define LAS __attribute__((address_space(3)))
typedef unsigned short bf16_t;
typedef short bf16x8 __attribute__((ext_vector_type(8)));
typedef short s16x4 __attribute__((ext_vector_type(4)));
typedef short v4i16_t __attribute__((ext_vector_type(4)));
typedef float f32x4 __attribute__((ext_vector_type(4)));
typedef unsigned u32x4 __attribute__((ext_vector_type(4)));
typedef unsigned u32x2 __attribute__((ext_vector_type(2)));

constexpr int S = 16384, D = 1024, FF = 2816, DEPTH = 4, NZ = 7936, INC = 7704;
constexpr float ALPHA = 1.6817928305074292f;
constexpr float LN_EPS = 1e-5f;
constexpr float LOG2E = 1.4426950408889634f;
constexpr float QK_SC = 0.125f * LOG2E;
constexpr int NTHR = 512;
constexpr int LDS_BYTES = 147456;

constexpr size_t MiB = 1u << 20;
constexpr size_t W_GU1 = 1 * MiB;
constexpr size_t W_D1 = W_GU1 + (size_t)5632 * 1024 * 2;
constexpr size_t W_GU2 = W_D1 + (size_t)1024 * 2816 * 2;
constexpr size_t W_D2 = W_GU2 + (size_t)5632 * 1024 * 2;
constexpr size_t W_IN = W_D2 + (size_t)1024 * 2816 * 2;
constexpr size_t W_A = W_IN + (size_t)NZ * 1024 * 2;
constexpr size_t W_B = W_A + (size_t)1024 * 512 * 2;
constexpr size_t W_C = W_B + (size_t)1024 * 256 * 2;
constexpr size_t W_O = W_C + (size_t)1024 * 512 * 2;
constexpr size_t W_P1K = W_O + (size_t)1024 * 1024 * 2;
constexpr size_t W_P1V = W_P1K + (size_t)128 * 2048 * 2;
constexpr size_t W_P2K = W_P1V + (size_t)128 * 2048 * 2;
constexpr size_t W_P2V = W_P2K + (size_t)64 * 128 * 2;
constexpr size_t W_SGU = W_P2V + (size_t)64 * 128 * 2;
constexpr size_t W_PB = W_SGU + (size_t)4 * 128 * 128 * 2;
constexpr size_t W_END = W_PB + 2 * 128 * 4;
static_assert(W_END <= 57 * MiB, "weights region");
constexpr size_t WS_COS = 57 * MiB, WS_SIN = 59 * MiB;
constexpr size_t WS_XB = 61 * MiB;
constexpr size_t WS_V32 = 93 * MiB, WS_OA32 = WS_V32;
constexpr size_t WS_H = 157 * MiB;
constexpr size_t WS_QAR = 157 * MiB, WS_QAT = 173 * MiB, WS_KS = 189 * MiB, WS_KW = 193 * MiB, WS_KC = 197 * MiB, WS_VC = 201 * MiB, WS_VS = 205 * MiB, WS_VW = 209 * MiB;
constexpr size_t WS_QB = 213 * MiB, WS_KB = 237 * MiB, WS_VB = 261 * MiB, WS_UVG = 285 * MiB, WS_GM = 317 * MiB, WS_GA = 413 * MiB;
constexpr size_t WS_M32 = 213 * MiB, WS_MB = 285 * MiB;
constexpr size_t WS_OA = 415 * MiB, WS_OB = 431 * MiB, WS_OC = 439 * MiB, WS_OD = 455 * MiB, WS_LSE = 479 * MiB, WS_SEL = 480 * MiB, WS_KCMP = 481 * MiB, WS_VCMP = 481 * MiB + 512 * 1024;
constexpr size_t WS_END = 482 * MiB;

struct Args { const float* in[24]; float* out; unsigned char* ws; float inv[32]; };
typedef const __attribute__((address_space(4))) Args* ArgsP;

__device__ __forceinline__ unsigned f2bf(float f) { unsigned u = __builtin_bit_cast(unsigned, f); return (u + 0x7fffu + ((u >> 16) & 1u)) >> 16; }
__device__ __forceinline__ unsigned pk2(float lo, float hi) { return pg8::cvt_pk_bf16(lo, hi); }
__device__ __forceinline__ float bf2f(unsigned short b) { return __builtin_bit_cast(float, (unsigned)b << 16); }
__device__ __forceinline__ float bflo(unsigned w) { return __builtin_bit_cast(float, w << 16); }
__device__ __forceinline__ float bfhi(unsigned w) { return __builtin_bit_cast(float, w & 0xffff0000u); }
__device__ __forceinline__ float fexp2(float x) { return __builtin_amdgcn_exp2f(x); }
__device__ __forceinline__ float frcp(float x) { return __builtin_amdgcn_rcpf(x); }
__device__ __forceinline__ float sigmoidf_(float x) { return frcp(1.0f + fexp2(-x * LOG2E)); }
__device__ __forceinline__ float siluf_(float x) { return x * sigmoidf_(x); }
__device__ __forceinline__ float gelu_tanh(float x) { const float u = 0.7978845608028654f * (x + 0.044715f * x * x * x); return x * frcp(1.0f + fexp2(-2.0f * LOG2E * u)); }
__device__ __forceinline__ float wave_sum(float v) {
#pragma unroll
    for (int o = 1; o < 64; o <<= 1) v += __shfl_xor(v, o);
    return v;
}
__device__ __forceinline__ f32x4 mfma16(bf16x8 a, bf16x8 b, f32x4 c) { return __builtin_amdgcn_mfma_f32_16x16x32_bf16(a, b, c, 0, 0, 0); }
__device__ __forceinline__ s16x4 tr_read(LAS const unsigned char* p) { return __builtin_bit_cast(s16x4, __builtin_amdgcn_ds_read_tr16_b64_v4i16((LAS v4i16_t*)p)); }
__device__ __forceinline__ bf16x8 cat8(s16x4 lo, s16x4 hi) { return (bf16x8){lo[0], lo[1], lo[2], lo[3], hi[0], hi[1], hi[2], hi[3]}; }
__device__ __forceinline__ bf16x8 pack8(const float (&p)[8]) {
    u32x4 w; w.x = pk2(p[0], p[1]); w.y = pk2(p[2], p[3]); w.z = pk2(p[4], p[5]); w.w = pk2(p[6], p[7]);
    return __builtin_bit_cast(bf16x8, w);
}

struct EpiFfn {
    static constexpr bool PERM = true, AFTER_DRAIN = false;
    bf16_t* H;
    __device__ __forceinline__ void operator()(const f32x4 (&acc)[2][2][4][2], const pg8::Unit& u, int wr, int wc, int fr, int fq) const {
        const int row0 = u.pm * 256 + wr * 64 + fr, col0 = u.pn * 128 + wc * 32 + 8 * fq;
#pragma unroll
        for (int ai = 0; ai < 2; ++ai)
#pragma unroll
            for (int m = 0; m < 4; ++m) {
                bf16_t* rowp = H + (size_t)(row0 + ai * 128 + m * 16) * FF + col0;
                float h[8];
#pragma unroll
                for (int n = 0; n < 2; ++n)
#pragma unroll
                    for (int i = 0; i < 4; ++i) h[4 * n + i] = siluf_(acc[ai][0][m][n][i]) * acc[ai][1][m][n][i];
                u32x4 w; w.x = pk2(h[0], h[1]); w.y = pk2(h[2], h[3]); w.z = pk2(h[4], h[5]); w.w = pk2(h[6], h[7]);
                *(u32x4*)rowp = w;
            }
    }
};
struct EpiRes {
    static constexpr bool PERM = false, AFTER_DRAIN = false;
    const float* X; float* V; float sc;
    __device__ __forceinline__ void operator()(const f32x4 (&acc)[2][2][4][2], const pg8::Unit& u, int wr, int wc, int fr, int fq) const {
        const int row0 = u.pm * 256 + wr * 64 + fr, col0 = u.pn * 256 + wc * 32 + 4 * fq;
#pragma unroll
        for (int ai = 0; ai < 2; ++ai)
#pragma unroll
            for (int m = 0; m < 4; ++m) {
                const size_t off = (size_t)(row0 + ai * 128 + m * 16) * D + col0;
#pragma unroll
                for (int bj = 0; bj < 2; ++bj)
#pragma unroll
                    for (int n = 0; n < 2; ++n) {
                        const f32x4 x = *(const f32x4*)(X + off + bj * 128 + n * 16);
                        *(f32x4*)(V + off + bj * 128 + n * 16) = x * ALPHA + acc[ai][bj][m][n] * sc;
                    }
            }
    }
};
struct EpiGate {
    static constexpr bool PERM = true, AFTER_DRAIN = false;
    const bf16_t* GM; float* M32; bf16_t* MB; int goff, mode;
    __device__ __forceinline__ void operator()(const f32x4 (&acc)[2][2][4][2], const pg8::Unit& u, int wr, int wc, int fr, int fq) const {
        const int row0 = u.pm * 256 + wr * 64 + fr, col0 = u.pn * 256 + wc * 32 + 8 * fq;
#pragma unroll
        for (int ai = 0; ai < 2; ++ai)
#pragma unroll
            for (int m = 0; m < 4; ++m) {
                const int row = row0 + ai * 128 + m * 16;
#pragma unroll
                for (int bj = 0; bj < 2; ++bj) {
                    const int col = col0 + bj * 128;
                    const u32x4 gw = *(const u32x4*)(GM + (size_t)row * 3072 + goff + col);
                    float v[8];
                    v[0] = bflo(gw.x) * acc[ai][bj][m][0][0]; v[1] = bfhi(gw.x) * acc[ai][bj][m][0][1]; v[2] = bflo(gw.y) * acc[ai][bj][m][0][2]; v[3] = bfhi(gw.y) * acc[ai][bj][m][0][3];
                    v[4] = bflo(gw.z) * acc[ai][bj][m][1][0]; v[5] = bfhi(gw.z) * acc[ai][bj][m][1][1]; v[6] = bflo(gw.w) * acc[ai][bj][m][1][2]; v[7] = bfhi(gw.w) * acc[ai][bj][m][1][3];
                    float* mp = M32 + (size_t)row * D + col;
                    if (mode != 0) { const f32x4 a = *(const f32x4*)mp, b = *(const f32x4*)(mp + 4); v[0] += a[0]; v[1] += a[1]; v[2] += a[2]; v[3] += a[3]; v[4] += b[0]; v[5] += b[1]; v[6] += b[2]; v[7] += b[3]; }
                    if (mode != 2) { *(f32x4*)mp = (f32x4){v[0], v[1], v[2], v[3]}; *(f32x4*)(mp + 4) = (f32x4){v[4], v[5], v[6], v[7]}; }
                    else { u32x4 w; w.x = pk2(v[0], v[1]); w.y = pk2(v[2], v[3]); w.z = pk2(v[4], v[5]); w.w = pk2(v[6], v[7]); *(u32x4*)(MB + (size_t)row * D + col) = w; }
                }
            }
    }
};
struct EpiZ {
    static constexpr bool PERM = true, AFTER_DRAIN = false;
    unsigned char* ws;
    __device__ __forceinline__ void operator()(const f32x4 (&acc)[2][2][4][2], const pg8::Unit& u, int wr, int wc, int fr, int fq) const {
        const int pn = u.pn, row0 = u.pm * 256 + wr * 64 + fr;
        if (pn <= 8) {
            bf16_t* dst; bf16_t* raw = nullptr; int ld, hcol;
            if (pn <= 1) { dst = (bf16_t*)(ws + WS_QAT); raw = (bf16_t*)(ws + WS_QAR); ld = 512; hcol = (pn * 4 + wc) * 64; }
            else if (pn == 2) { dst = (bf16_t*)(ws + (wc < 2 ? WS_KS : WS_KW)); ld = 128; hcol = (wc & 1) * 64; }
            else if (pn <= 5) { dst = (bf16_t*)(ws + WS_QB); ld = 768; hcol = ((pn - 3) * 4 + wc) * 64; }
            else { dst = (bf16_t*)(ws + WS_KB); ld = 768; hcol = ((pn - 6) * 4 + wc) * 64; }
            const float* ct = (const float*)(ws + WS_COS); const float* st = (const float*)(ws + WS_SIN);
#pragma unroll
            for (int ai = 0; ai < 2; ++ai)
#pragma unroll
                for (int m = 0; m < 4; ++m) {
                    const int row = row0 + ai * 128 + m * 16;
                    const f32x4 c0 = *(const f32x4*)(ct + row * 32 + 8 * fq), c1 = *(const f32x4*)(ct + row * 32 + 8 * fq + 4);
                    const f32x4 s0 = *(const f32x4*)(st + row * 32 + 8 * fq), s1 = *(const f32x4*)(st + row * 32 + 8 * fq + 4);
                    const f32x4 a0 = acc[ai][0][m][0], a1 = acc[ai][0][m][1], b0 = acc[ai][1][m][0], b1 = acc[ai][1][m][1];
                    const f32x4 o10 = a0 * c0 - b0 * s0, o11 = a1 * c1 - b1 * s1, o20 = b0 * c0 + a0 * s0, o21 = b1 * c1 + a1 * s1;
                    bf16_t* p = dst + (size_t)row * ld + hcol + 8 * fq;
                    u32x4 w; w.x = pk2(o10[0], o10[1]); w.y = pk2(o10[2], o10[3]); w.z = pk2(o11[0], o11[1]); w.w = pk2(o11[2], o11[3]); *(u32x4*)p = w;
                    w.x = pk2(o20[0], o20[1]); w.y = pk2(o20[2], o20[3]); w.z = pk2(o21[0], o21[1]); w.w = pk2(o21[2], o21[3]); *(u32x4*)(p + 32) = w;
                    if (raw) { bf16_t* q = raw + (size_t)row * ld + hcol + 8 * fq;
                        w.x = pk2(a0[0], a0[1]); w.y = pk2(a0[2], a0[3]); w.z = pk2(a1[0], a1[1]); w.w = pk2(a1[2], a1[3]); *(u32x4*)q = w;
                        w.x = pk2(b0[0], b0[1]); w.y = pk2(b0[2], b0[3]); w.z = pk2(b1[0], b1[1]); w.w = pk2(b1[2], b1[3]); *(u32x4*)(q + 32) = w; }
                }
        } else if (pn <= 29) {
            const int act = pn <= 13 ? 0 : (pn <= 17 ? 1 : 2);
#pragma unroll
            for (int bj = 0; bj < 2; ++bj) {
                bf16_t* dst; int ld, c0;
                if (pn == 9) { dst = (bf16_t*)(ws + (bj ? WS_VC : WS_KC)); ld = 128; c0 = 0; }
                else if (pn == 10) { dst = (bf16_t*)(ws + (bj ? WS_VW : WS_VS)); ld = 128; c0 = 0; }
                else if (pn <= 13) { dst = (bf16_t*)(ws + WS_VB); ld = 768; c0 = (pn - 11) * 256 + bj * 128; }
                else if (pn <= 17) { dst = (bf16_t*)(ws + WS_UVG); ld = 1024; c0 = (pn - 14) * 256 + bj * 128; }
                else { dst = (bf16_t*)(ws + WS_GM); ld = 3072; c0 = (pn - 18) * 256 + bj * 128; }
                c0 += wc * 32 + 8 * fq;
#pragma unroll
                for (int ai = 0; ai < 2; ++ai)
#pragma unroll
                    for (int m = 0; m < 4; ++m) {
                        const int row = row0 + ai * 128 + m * 16;
                        float v[8];
#pragma unroll
                        for (int n = 0; n < 2; ++n)
#pragma unroll
                            for (int i = 0; i < 4; ++i) { const float x = acc[ai][bj][m][n][i]; v[4 * n + i] = act == 0 ? x : (act == 1 ? gelu_tanh(x) : sigmoidf_(x)); }
                        u32x4 w; w.x = pk2(v[0], v[1]); w.y = pk2(v[2], v[3]); w.z = pk2(v[4], v[5]); w.w = pk2(v[6], v[7]);
                        *(u32x4*)(dst + (size_t)row * ld + c0) = w;
                    }
            }
        } else {
            if (wc == 0 && fq < 3) {
                float* ga = (float*)(ws + WS_GA);
#pragma unroll
                for (int ai = 0; ai < 2; ++ai)
#pragma unroll
                    for (int m = 0; m < 4; ++m) {
                        const int row = row0 + ai * 128 + m * 16;
#pragma unroll
                        for (int n = 0; n < 2; ++n) { const f32x4 x = acc[ai][0][m][n];
                            *(f32x4*)(ga + (size_t)row * 24 + 8 * fq + 4 * n) = (f32x4){sigmoidf_(x[0]), sigmoidf_(x[1]), sigmoidf_(x[2]), sigmoidf_(x[3])}; }
                    }
            }
        }
    }
};

__device__ __forceinline__ int win_col0(int dg) {
    const int pn = dg >> 3, q = dg & 7, hs = q & 3, half = q >> 2;
    if (pn <= 1) return (pn * 4 + hs) * 64 + 32 * half;
    if (pn == 2) return (hs == 0 ? 768 : hs == 1 ? 832 : hs == 2 ? 1024 : 1088) + 32 * half;
    if (pn <= 5) return 1304 + ((pn - 3) * 4 + hs) * 64 + 32 * half;
    if (pn <= 8) return 2072 + ((pn - 6) * 4 + hs) * 64 + 32 * half;
    if (pn == 9) return (q < 4 ? 512 : 640) + 32 * (q & 3);
    if (pn == 10) return (q < 4 ? 896 : 1152) + 32 * (q & 3);
    if (pn <= 13) return 2840 + (pn - 11) * 256 + 32 * q;
    if (pn <= 17) return 3608 + (pn - 14) * 256 + 32 * q;
    if (pn <= 29) return 4632 + (pn - 18) * 256 + 32 * q;
    return q == 0 ? 1280 : -1;
}

__device__ __forceinline__ void transpose_item(const float* W, int ldw, int col0, int k0, bf16_t* dst, int K, LAS float* scr, int lane) {
    if (col0 >= 0) {
#pragma unroll 8
        for (int i = 0; i < 32; ++i) { const int kk = 2 * i + (lane >> 5); scr[kk * 33 + (lane & 31)] = W[(size_t)(k0 + kk) * ldw + col0 + (lane & 31)]; }
    } else {
#pragma unroll 8
        for (int i = 0; i < 32; ++i) { const int kk = 2 * i + (lane >> 5); scr[kk * 33 + (lane & 31)] = 0.f; }
    }
    asm volatile("s_waitcnt lgkmcnt(0)" ::: "memory");
    const int c = lane & 7;
#pragma unroll
    for (int j = 0; j < 4; ++j) { const int n = (lane >> 3) + 8 * j; const LAS float* s = scr + (8 * c) * 33 + n;
        u32x4 o; o.x = pk2(s[0 * 33], s[1 * 33]); o.y = pk2(s[2 * 33], s[3 * 33]); o.z = pk2(s[4 * 33], s[5 * 33]); o.w = pk2(s[6 * 33], s[7 * 33]);
        *(u32x4*)(dst + (size_t)n * K + 8 * c) = o; }
    asm volatile("s_waitcnt lgkmcnt(0)" ::: "memory");
}

__device__ __forceinline__ void prologue_phase(ArgsP a, int l, LAS unsigned char* lds, int tid, int bid, int G) {
    const int lane = tid & 63, wave = tid >> 6;
    LAS float* scr = (LAS float*)(lds + wave * 16384);
    unsigned char* ws = a->ws;
    const int gw = bid * 8 + wave, NGW = G * 8;
    const float* g1 = a->in[3] + (size_t)l * D * FF; const float* u1 = a->in[4] + (size_t)l * D * FF; const float* d1 = a->in[5] + (size_t)l * FF * D;
    const float* g2 = a->in[6] + (size_t)l * D * FF; const float* u2 = a->in[7] + (size_t)l * D * FF; const float* d2 = a->in[8] + (size_t)l * FF * D;
    const float* win = a->in[9] + (size_t)l * D * INC;
    const float* pkw1 = a->in[11] + (size_t)l * 2048 * 128; const float* pkw2 = a->in[12] + (size_t)l * 128 * 64;
    const float* pvw1 = a->in[14] + (size_t)l * 2048 * 128; const float* pvw2 = a->in[15] + (size_t)l * 128 * 64;
    const float* wa = a->in[20] + (size_t)l * 512 * D; const float* wb = a->in[21] + (size_t)l * 256 * D; const float* wc = a->in[22] + (size_t)l * 512 * D; const float* wo = a->in[23] + (size_t)l * D * D;
    constexpr int I_GU = 16 * 176, I_D = 44 * 32, I_IN = 16 * 248, I_A = 8 * 32, I_B = 4 * 32, I_O = 16 * 32, I_P1 = 32 * 4, I_P2 = 2 * 2;
    constexpr int NIT = 2 * I_GU + 2 * I_D + I_IN + 2 * I_A + I_B + I_O + 2 * I_P1 + 2 * I_P2;
    for (int it = gw; it < NIT; it += NGW) {
        int r = it; const float* src; int ldw, col0, kb, dg, K; size_t dbase;
        if (r < 2 * I_GU) { const int f = r >= I_GU; if (f) r -= I_GU; kb = r / 176; dg = r % 176; const int pn = dg >> 3, q = dg & 7;
            src = (q < 4) ? (f ? g2 : g1) : (f ? u2 : u1); ldw = FF; col0 = 128 * pn + 32 * (q & 3); K = 1024; dbase = f ? W_GU2 : W_GU1; }
        else if ((r -= 2 * I_GU) < 2 * I_D) { const int f = r >= I_D; if (f) r -= I_D; kb = r / 32; dg = r % 32; src = f ? d2 : d1; ldw = D; col0 = 32 * dg; K = FF; dbase = f ? W_D2 : W_D1; }
        else if ((r -= 2 * I_D) < I_IN) { kb = r / 248; dg = r % 248; src = win; ldw = INC; col0 = win_col0(dg); K = 1024; dbase = W_IN; }
        else if ((r -= I_IN) < I_A) { kb = r / 32; dg = r % 32; src = wa; ldw = D; col0 = 32 * dg; K = 512; dbase = W_A; }
        else if ((r -= I_A) < I_A) { kb = r / 32; dg = r % 32; src = wc; ldw = D; col0 = 32 * dg; K = 512; dbase = W_C; }
        else if ((r -= I_A) < I_B) { kb = r / 32; dg = r % 32; src = wb; ldw = D; col0 = 32 * dg; K = 256; dbase = W_B; }
        else if ((r -= I_B) < I_O) { kb = r / 32; dg = r % 32; src = wo; ldw = D; col0 = 32 * dg; K = 1024; dbase = W_O; }
        else if ((r -= I_O) < 2 * I_P1) { const int f = r >= I_P1; if (f) r -= I_P1; kb = r / 4; dg = r % 4; src = f ? pvw1 : pkw1; ldw = 128; col0 = 32 * dg; K = 2048; dbase = f ? W_P1V : W_P1K; }
        else { r -= 2 * I_P1; const int f = r >= I_P2; if (f) r -= I_P2; kb = r / 2; dg = r % 2; src = f ? pvw2 : pkw2; ldw = 64; col0 = 32 * dg; K = 128; dbase = f ? W_P2V : W_P2K; }
        transpose_item(src, ldw, col0, kb * 64, (bf16_t*)(ws + dbase) + (size_t)dg * 32 * K + kb * 64, K, scr, lane);
    }
    { const float* sw = a->in[18] + (size_t)l * 4 * 128 * 128; bf16_t* o = (bf16_t*)(ws + W_SGU);
      for (int i = bid * NTHR + tid; i < 4 * 128 * 128; i += G * NTHR) { const int t = (i >> 7) & 127, s = i & 127; o[i] = (bf16_t)f2bf(s <= t ? sw[i] : 0.f); } }
    for (int o = gw; o < 256; o += NGW) {
        const int which = o >> 7, c = o & 127;
        const float* pos = a->in[which ? 13 : 10] + (size_t)l * 2048; const float* w1 = which ? pvw1 : pkw1;
        float s = 0.f;
        for (int kk = lane; kk < 2048; kk += 64) s += pos[kk] * w1[(size_t)kk * 128 + c];
        s = wave_sum(s);
        if (lane == 0) ((float*)(ws + W_PB))[o] = s;
    }
    if (l == 0) {
        const f32x4* x4 = (const f32x4*)a->in[0]; u32x2* xb = (u32x2*)(ws + WS_XB);
        for (size_t i = (size_t)bid * NTHR + tid; i < (size_t)S * D / 4; i += (size_t)G * NTHR) { const f32x4 v = x4[i]; u32x2 w; w.x = pk2(v[0], v[1]); w.y = pk2(v[2], v[3]); xb[i] = w; }
        float* ct = (float*)(ws + WS_COS); float* st = (float*)(ws + WS_SIN);
        for (int i = bid * NTHR + tid; i < S * 32; i += G * NTHR) {
            const int t = i >> 5, d = i & 31;
            const float angf = (float)t * a->inv[d];
            const double ang = (double)angf;
            const double kq = rint(ang * 0.63661977236758134308);
            const double rr = (ang - kq * 1.57079632673412561417) - kq * 6.07710050650619224932e-11;
            const double r2 = rr * rr;
#define DC(x) ([](double v_) { asm volatile("" : "+s"(v_)); return v_; }(x))
            double sn = DC(1.0 / 6227020800.0); sn = sn * r2 + DC(-1.0 / 39916800); sn = sn * r2 + DC(1.0 / 362880); sn = sn * r2 + DC(-1.0 / 5040); sn = sn * r2 + DC(1.0 / 120); sn = sn * r2 + DC(-1.0 / 6); sn = rr + rr * r2 * sn;
            double cs = DC(-1.0 / 87178291200.0); cs = cs * r2 + DC(1.0 / 479001600); cs = cs * r2 + DC(-1.0 / 3628800); cs = cs * r2 + DC(1.0 / 40320); cs = cs * r2 + DC(-1.0 / 720); cs = cs * r2 + DC(1.0 / 24); cs = cs * r2 + DC(-0.5); cs = 1.0 + r2 * cs;
#undef DC
            const int qd = ((int)kq) & 3;
            const double c = qd == 0 ? cs : qd == 1 ? -sn : qd == 2 ? -cs : sn;
            const double s = qd == 0 ? sn : qd == 1 ? cs : qd == 2 ? -sn : -cs;
            ct[i] = (float)c; st[i] = (float)s;
        }
    }
}

__device__ __forceinline__ void ln_phase(const float* V, const float* gam, const float* bet, float* X, bf16_t* XB, int tid, int bid, int G) {
    const int lane = tid & 63, wave = tid >> 6;
    const int gw = bid * 8 + wave, NGW = G * 8;
    f32x4 gv[4], bv[4];
#pragma unroll
    for (int j = 0; j < 4; ++j) { gv[j] = ((const f32x4*)gam)[64 * j + lane]; bv[j] = ((const f32x4*)bet)[64 * j + lane]; }
    for (int m = gw; m < S; m += NGW) {
        const f32x4* xr = (const f32x4*)(V + (size_t)m * D) + lane;
        f32x4 v[4]; float s = 0.f;
#pragma unroll
        for (int j = 0; j < 4; ++j) { v[j] = xr[64 * j]; s += (v[j][0] + v[j][1]) + (v[j][2] + v[j][3]); }
        const float mean = wave_sum(s) * (1.f / D); float s2 = 0.f;
#pragma unroll
        for (int j = 0; j < 4; ++j) { v[j] = v[j] - mean; s2 += (v[j][0] * v[j][0] + v[j][1] * v[j][1]) + (v[j][2] * v[j][2] + v[j][3] * v[j][3]); }
        const float rstd = 1.0f / sqrtf(wave_sum(s2) * (1.f / D) + LN_EPS);
        f32x4* xo = (f32x4*)(X + (size_t)m * D) + lane; u32x2* bo = (u32x2*)(XB + (size_t)m * D) + lane;
#pragma unroll
        for (int j = 0; j < 4; ++j) { const f32x4 y = v[j] * rstd * gv[j] + bv[j]; xo[64 * j] = y; u32x2 w; w.x = pk2(y[0], y[1]); w.y = pk2(y[2], y[3]); bo[64 * j] = w; }
    }
}

constexpr int RP = 144;
struct KFrag { bf16x8 a0, a1, b0, b1; };
__device__ __forceinline__ KFrag load_kfrag(LAS const unsigned char* Kt, int lane) {
    const int r = lane & 15, g = lane >> 4;
    LAS const unsigned char* ka = Kt + (8 * (r >> 2) + (r & 3)) * RP + g * 16;
    KFrag k; k.a0 = *(LAS const bf16x8*)ka; k.a1 = *(LAS const bf16x8*)(ka + 64); k.b0 = *(LAS const bf16x8*)(ka + 4 * RP); k.b1 = *(LAS const bf16x8*)(ka + 4 * RP + 64);
    return k;
}
__device__ __forceinline__ void load_vfrag(bf16x8 (&vf)[4], LAS const unsigned char* Vt, int lane) {
    const int r = lane & 15, g = lane >> 4;
    LAS const unsigned char* vb = Vt + (8 * g + (r >> 2)) * RP + (lane & 3) * 8;
#pragma unroll
    for (int c = 0; c < 4; ++c) vf[c] = cat8(tr_read(vb + c * 32), tr_read(vb + 4 * RP + c * 32));
}
__device__ __forceinline__ void scores8(float (&s)[8], const KFrag& k, const bf16x8 (&qf)[2]) {
    const f32x4 z = {0.f, 0.f, 0.f, 0.f};
    f32x4 sa = mfma16(k.a0, qf[0], z); sa = mfma16(k.a1, qf[1], sa);
    f32x4 sb = mfma16(k.b0, qf[0], z); sb = mfma16(k.b1, qf[1], sb);
    s[0] = sa[0]; s[1] = sa[1]; s[2] = sa[2]; s[3] = sa[3]; s[4] = sb[0]; s[5] = sb[1]; s[6] = sb[2]; s[7] = sb[3];
}
__device__ __forceinline__ float rmax4(float v) { v = fmaxf(v, __shfl_xor(v, 16)); return fmaxf(v, __shfl_xor(v, 32)); }
__device__ __forceinline__ float rsum4(float v) { v += __shfl_xor(v, 16); return v + __shfl_xor(v, 32); }

__device__ __forceinline__ void attn_tile_step(float& m, float& l, f32x4 (&o)[4], const bf16x8 (&qf)[2], const KFrag& k, const bf16x8 (&vf)[4], unsigned vmask) {
    float s[8]; scores8(s, k, qf);
    float mx = -1e30f;
#pragma unroll
    for (int e = 0; e < 8; ++e) { s[e] = ((vmask >> e) & 1u) ? s[e] * QK_SC : -1e30f; mx = fmaxf(mx, s[e]); }
    mx = rmax4(mx);
    const float mn = fmaxf(m, mx), corr = fexp2(m - mn);
    float p[8], rs = 0.f;
#pragma unroll
    for (int e = 0; e < 8; ++e) { p[e] = ((vmask >> e) & 1u) ? fexp2(s[e] - mn) : 0.f; rs += p[e]; }
    rs = rsum4(rs);
    l = l * corr + rs; m = mn;
    const bf16x8 pf = pack8(p);
#pragma unroll
    for (int c = 0; c < 4; ++c) { o[c] = o[c] * corr; o[c] = mfma16(vf[c], pf, o[c]); }
}

__device__ __forceinline__ void win_phase(unsigned char* ws, LAS unsigned char* lds, int tid, int bid, int G) {
    const int lane = tid & 63, wave = tid >> 6, r = lane & 15, g = lane >> 4;
    const bf16_t* Q = (const bf16_t*)(ws + WS_QAT); const bf16_t* Kg = (const bf16_t*)(ws + WS_KW); const bf16_t* Vg = (const bf16_t*)(ws + WS_VW);
    const float* GA = (const float*)(ws + WS_GA); float* OA32 = (float*)(ws + WS_OA32);
    LAS unsigned char* Kl = lds; LAS unsigned char* Vl = lds + 128 * RP;
    for (int u = bid; u < 512; u += G) {
        const int tile = u >> 1, grp = u & 1, t0 = tile * 64;
        const int kstart = t0 >= 512 ? t0 - 512 : 0, kend = t0 + 64;
        const int tw = t0 + 8 * wave;
        bf16x8 qf[2][2]; float m[2], l[2]; f32x4 o[2][4];
#pragma unroll
        for (int qt = 0; qt < 2; ++qt) {
            const int tok = tw + 4 * qt + (r >> 2), head = r & 3;
            const bf16_t* qp = Q + (size_t)tok * 512 + (grp * 4 + head) * 64 + 8 * g;
            qf[qt][0] = *(const bf16x8*)qp; qf[qt][1] = *(const bf16x8*)(qp + 32);
            m[qt] = -1e30f; l[qt] = 0.f;
#pragma unroll
            for (int c = 0; c < 4; ++c) o[qt][c] = (f32x4){0.f, 0.f, 0.f, 0.f};
        }
        for (int kc = kstart; kc < kend; kc += 128) {
            const int nrows = (kend - kc) < 128 ? (kend - kc) : 128;
            __syncthreads();
            for (int c = tid; c < nrows * 8; c += NTHR) { const int i = c >> 3, pc = c & 7;
                *(LAS u32x4*)(Kl + i * RP + pc * 16) = *(const u32x4*)(Kg + (size_t)(kc + i) * 128 + grp * 64 + pc * 8);
                *(LAS u32x4*)(Vl + i * RP + pc * 16) = *(const u32x4*)(Vg + (size_t)(kc + i) * 128 + grp * 64 + pc * 8); }
            __syncthreads();
            for (int st = 0; st < nrows / 32; ++st) {
                const int k0 = kc + 32 * st;
                if (k0 + 31 < tw - 511 || k0 > tw + 7) continue;
                const KFrag kf = load_kfrag(Kl + st * 32 * RP, lane);
                bf16x8 vf[4]; load_vfrag(vf, Vl + st * 32 * RP, lane);
#pragma unroll
                for (int qt = 0; qt < 2; ++qt) {
                    const int t = tw + 4 * qt + (r >> 2); unsigned vm = 0;
#pragma unroll
                    for (int e = 0; e < 8; ++e) { const int dlt = t - (k0 + 8 * g + e); vm |= (dlt >= 0 && dlt < 512) ? (1u << e) : 0u; }
                    attn_tile_step(m[qt], l[qt], o[qt], qf[qt], kf, vf, vm);
                }
            }
        }
#pragma unroll
        for (int qt = 0; qt < 2; ++qt) {
            const int tok = tw + 4 * qt + (r >> 2), head = r & 3, hh = grp * 4 + head;
            const float sc = GA[(size_t)tok * 24 + hh * 3 + 2] / fmaxf(l[qt], 1e-30f);
#pragma unroll
            for (int c = 0; c < 4; ++c) *(f32x4*)(OA32 + (size_t)tok * 512 + hh * 64 + 16 * c + 4 * g) = o[qt][c] * sc;
        }
    }
}

__device__ __forceinline__ void dil_phase(unsigned char* ws, LAS unsigned char* lds, int tid, int bid, int G) {
    const int lane = tid & 63, wave = tid >> 6, r = lane & 15, g = lane >> 4;
    const bf16_t* Q = (const bf16_t*)(ws + WS_QB); const bf16_t* Kg = (const bf16_t*)(ws + WS_KB); const bf16_t* Vg = (const bf16_t*)(ws + WS_VB);
    bf16_t* OD = (bf16_t*)(ws + WS_OD); float* LSE = (float*)(ws + WS_LSE);
    LAS unsigned char* Kl = lds; LAS unsigned char* Vl = lds + 256 * RP;
    for (int u = bid; u < 1536; u += G) {
        const int h = u >> 7, rem = u & 127, gi = h >> 2, hi = h & 3, dil = 1 << (2 * gi), nsub = 128 >> (2 * gi), rr = rem / nsub, n = rem % nsub;
        const int mbase = 128 * n - 128;
        __syncthreads();
        for (int c = tid; c < 256 * 8; c += NTHR) { const int i = c >> 3, pc = c & 7; const int mk = mbase + i;
            u32x4 kv = {0, 0, 0, 0}, vv = {0, 0, 0, 0};
            if (mk >= 0) { const size_t off = (size_t)(mk * dil + rr) * 768 + h * 64 + pc * 8; kv = *(const u32x4*)(Kg + off); vv = *(const u32x4*)(Vg + off); }
            *(LAS u32x4*)(Kl + i * RP + pc * 16) = kv; *(LAS u32x4*)(Vl + i * RP + pc * 16) = vv; }
        __syncthreads();
        const int mq = 128 * n + 16 * wave + r, tq = mq * dil + rr;
        bf16x8 qf[2]; { const bf16_t* qp = Q + (size_t)tq * 768 + h * 64 + 8 * g; qf[0] = *(const bf16x8*)qp; qf[1] = *(const bf16x8*)(qp + 32); }
        float m = -1e30f, l = 0.f; f32x4 o[4];
#pragma unroll
        for (int c = 0; c < 4; ++c) o[c] = (f32x4){0.f, 0.f, 0.f, 0.f};
        const int start = (16 * wave) & ~31;
        for (int st = 0; st < 5; ++st) {
            const int i0 = start + 32 * st;
            const KFrag kf = load_kfrag(Kl + i0 * RP, lane);
            bf16x8 vf[4]; load_vfrag(vf, Vl + i0 * RP, lane);
            unsigned vm = 0;
#pragma unroll
            for (int e = 0; e < 8; ++e) { const int mk = mbase + i0 + 8 * g + e; const int dlt = mq - mk; vm |= (dlt >= 0 && dlt <= 128 && mk >= 0) ? (1u << e) : 0u; }
            attn_tile_step(m, l, o, qf, kf, vf, vm);
        }
        const float il = 1.0f / fmaxf(l, 1e-30f);
        bf16_t* op = OD + ((size_t)gi * S + tq) * 256 + hi * 64 + 4 * g;
#pragma unroll
        for (int c = 0; c < 4; ++c) { u32x2 w; w.x = pk2(o[c][0] * il, o[c][1] * il); w.y = pk2(o[c][2] * il, o[c][3] * il); *(u32x2*)(op + 16 * c) = w; }
        if (g == 0) LSE[((size_t)gi * S + tq) * 4 + hi] = m + log2f(fmaxf(l, 1e-30f));
    }
}
__device__ __forceinline__ void dil_combine(unsigned char* ws, int tid, int bid, int G) {
    const bf16_t* OD = (const bf16_t*)(ws + WS_OD); const float* LSE = (const float*)(ws + WS_LSE); bf16_t* OB = (bf16_t*)(ws + WS_OB);
    for (int i = bid * NTHR + tid; i < S * 32; i += G * NTHR) {
        const int t = i >> 5, hi = (i >> 3) & 3, ch = i & 7;
        const float l0 = LSE[(size_t)t * 4 + hi], l1 = LSE[((size_t)S + t) * 4 + hi], l2 = LSE[((size_t)2 * S + t) * 4 + hi];
        const float mx = fmaxf(l0, fmaxf(l1, l2));
        float w0 = fexp2(l0 - mx), w1 = fexp2(l1 - mx), w2 = fexp2(l2 - mx); const float iw = 1.0f / (w0 + w1 + w2); w0 *= iw; w1 *= iw; w2 *= iw;
        const size_t off = (size_t)t * 256 + hi * 64 + ch * 8;
        const u32x4 a = *(const u32x4*)(OD + off), b = *(const u32x4*)(OD + (size_t)S * 256 + off), c = *(const u32x4*)(OD + (size_t)2 * S * 256 + off);
        u32x4 w;
        w.x = pk2(w0 * bflo(a.x) + w1 * bflo(b.x) + w2 * bflo(c.x), w0 * bfhi(a.x) + w1 * bfhi(b.x) + w2 * bfhi(c.x));
        w.y = pk2(w0 * bflo(a.y) + w1 * bflo(b.y) + w2 * bflo(c.y), w0 * bfhi(a.y) + w1 * bfhi(b.y) + w2 * bfhi(c.y));
        w.z = pk2(w0 * bflo(a.z) + w1 * bflo(b.z) + w2 * bflo(c.z), w0 * bfhi(a.z) + w1 * bfhi(b.z) + w2 * bfhi(c.z));
        w.w = pk2(w0 * bflo(a.w) + w1 * bflo(b.w) + w2 * bflo(c.w), w0 * bfhi(a.w) + w1 * bfhi(b.w) + w2 * bfhi(c.w));
        *(u32x4*)(OB + off) = w;
    }
}

__device__ __forceinline__ void sgu_phase(ArgsP a, unsigned char* ws, int l, LAS unsigned char* lds, int tid, int bid, int G) {
    constexpr int VRP = 272;
    const int lane = tid & 63, wave = tid >> 6, r = lane & 15, g = lane >> 4;
    const bf16_t* UVG = (const bf16_t*)(ws + WS_UVG); bf16_t* OC = (bf16_t*)(ws + WS_OC); const bf16_t* WSB = (const bf16_t*)(ws + W_SGU);
    const float* lng = a->in[16] + (size_t)l * 512; const float* lnb = a->in[17] + (size_t)l * 512; const float* sb = a->in[19] + (size_t)l * 512;
    LAS unsigned char* vh = lds;
    for (int u = bid; u < 512; u += G) {
        const int n = u >> 2, grp = u & 3, t0 = n * 128;
        __syncthreads();
        for (int tt = 0; tt < 16; ++tt) {
            const int tl = 16 * wave + tt;
            const u32x4 w = *(const u32x4*)(UVG + (size_t)(t0 + tl) * 1024 + 512 + 8 * lane);
            float v[8] = {bflo(w.x), bfhi(w.x), bflo(w.y), bfhi(w.y), bflo(w.z), bfhi(w.z), bflo(w.w), bfhi(w.w)};
            float s = 0.f;
#pragma unroll
            for (int e = 0; e < 8; ++e) s += v[e];
            const float mean = wave_sum(s) * (1.f / 512); float s2 = 0.f;
#pragma unroll
            for (int e = 0; e < 8; ++e) { v[e] -= mean; s2 += v[e] * v[e]; }
            const float rstd = 1.0f / sqrtf(wave_sum(s2) * (1.f / 512) + LN_EPS);
            if ((lane >> 4) == grp) {
                float y[8];
#pragma unroll
                for (int e = 0; e < 8; ++e) y[e] = v[e] * rstd * lng[8 * lane + e] + lnb[8 * lane + e];
                u32x4 o; o.x = pk2(y[0], y[1]); o.y = pk2(y[2], y[3]); o.z = pk2(y[4], y[5]); o.w = pk2(y[6], y[7]);
                *(LAS u32x4*)(vh + tl * VRP + (8 * lane - 128 * grp) * 2) = o;
            }
        }
        __syncthreads();
        f32x4 acc[8];
#pragma unroll
        for (int c = 0; c < 8; ++c) acc[c] = (f32x4){0.f, 0.f, 0.f, 0.f};
        const int nst = (16 * wave + 15) / 32 + 1;
        for (int ks = 0; ks < nst; ++ks) {
            const bf16x8 bfr = *(const bf16x8*)(WSB + ((size_t)grp * 128 + 16 * wave + r) * 128 + 32 * ks + 8 * g);
            LAS const unsigned char* vb = vh + (32 * ks + 8 * g + (r >> 2)) * VRP + (lane & 3) * 8;
#pragma unroll
            for (int c = 0; c < 8; ++c) { const bf16x8 af = cat8(tr_read(vb + c * 32), tr_read(vb + 4 * VRP + c * 32)); acc[c] = mfma16(af, bfr, acc[c]); }
        }
        const int tl = 16 * wave + r; const float bias = sb[grp * 128 + tl];
        const bf16_t* up = UVG + (size_t)(t0 + tl) * 1024 + grp * 128 + 4 * g; bf16_t* op = OC + (size_t)(t0 + tl) * 512 + grp * 128 + 4 * g;
#pragma unroll
        for (int c = 0; c < 8; ++c) { const u32x2 uw = *(const u32x2*)(up + 16 * c);
            u32x2 w; w.x = pk2(bflo(uw.x) * (acc[c][0] + bias), bfhi(uw.x) * (acc[c][1] + bias)); w.y = pk2(bflo(uw.y) * (acc[c][2] + bias), bfhi(uw.y) * (acc[c][3] + bias));
            *(u32x2*)(op + 16 * c) = w; }
    }
}

__device__ __forceinline__ void cmp_mlp_phase(unsigned char* ws, LAS unsigned char* lds, int tid, int bid, int G) {
    const int lane = tid & 63, wave = tid >> 6, r = lane & 15, g = lane >> 4;
    LAS float* red = (LAS float*)lds; LAS unsigned char* hid = lds + 65536;
    for (int u = bid; u < 256; u += G) {
        const int which = u >> 7, grp = (u >> 6) & 1, rt = u & 63;
        const bf16_t* src = (const bf16_t*)(ws + (which ? WS_VC : WS_KC)); const bf16_t* w1t = (const bf16_t*)(ws + (which ? W_P1V : W_P1K)); const bf16_t* w2t = (const bf16_t*)(ws + (which ? W_P2V : W_P2K));
        const float* pb = (const float*)(ws + W_PB) + which * 128; bf16_t* dst = (bf16_t*)(ws + (which ? WS_VCMP : WS_KCMP));
        f32x4 acc[8];
#pragma unroll
        for (int c = 0; c < 8; ++c) acc[c] = (f32x4){0.f, 0.f, 0.f, 0.f};
        for (int ks = 0; ks < 8; ++ks) {
            const int j = 4 * wave + (ks >> 1), d0 = (ks & 1) * 32 + 8 * g, tok = 16 * (16 * rt + r) + j;
            bf16x8 af = {0, 0, 0, 0, 0, 0, 0, 0};
            if (tok < S) af = *(const bf16x8*)(src + (size_t)tok * 128 + grp * 64 + d0);
#pragma unroll
            for (int c = 0; c < 8; ++c) { const bf16x8 bfr = *(const bf16x8*)(w1t + (size_t)(16 * c + r) * 2048 + 256 * wave + 32 * ks + 8 * g); acc[c] = mfma16(af, bfr, acc[c]); }
        }
        __syncthreads();
#pragma unroll
        for (int c = 0; c < 8; ++c)
#pragma unroll
            for (int i = 0; i < 4; ++i) red[wave * 2048 + (4 * g + i) * 128 + 16 * c + r] = acc[c][i];
        __syncthreads();
#pragma unroll
        for (int q = 0; q < 4; ++q) { const int idx = tid * 4 + q, row = idx >> 7, col = idx & 127; float s = pb[col];
#pragma unroll
            for (int w = 0; w < 8; ++w) s += red[w * 2048 + idx];
            *(LAS bf16_t*)(hid + row * 272 + col * 2) = (bf16_t)f2bf(gelu_tanh(s)); }
        __syncthreads();
        if (wave < 4) {
            f32x4 a2 = {0.f, 0.f, 0.f, 0.f};
#pragma unroll
            for (int ks = 0; ks < 4; ++ks) { const bf16x8 af = *(LAS const bf16x8*)(hid + r * 272 + (32 * ks + 8 * g) * 2); const bf16x8 bfr = *(const bf16x8*)(w2t + (size_t)(16 * wave + r) * 128 + 32 * ks + 8 * g); a2 = mfma16(af, bfr, a2); }
#pragma unroll
            for (int i = 0; i < 4; ++i) dst[((size_t)grp * 1024 + 16 * rt + 4 * g + i) * 64 + 16 * wave + r] = (bf16_t)f2bf(a2[i]);
        }
    }
}

__device__ __forceinline__ void cmp_attn_phase(unsigned char* ws, LAS unsigned char* lds, int tid, int bid, int G) {
    const int lane = tid & 63, wave = tid >> 6, r = lane & 15, g = lane >> 4;
    const bf16_t* Q = (const bf16_t*)(ws + WS_QAR); const float* GA = (const float*)(ws + WS_GA); float* OA32 = (float*)(ws + WS_OA32); unsigned* SEL = (unsigned*)(ws + WS_SEL);
    LAS unsigned char* Kl = lds; LAS unsigned char* Vl = lds + 128 * RP; LAS float* pslc = (LAS float*)(lds + 65536);
    for (int u = bid; u < 1024; u += G) {
        const int tile = u >> 1, grp = u & 1, t0 = tile * 32;
        const bf16_t* Kg = (const bf16_t*)(ws + WS_KCMP) + (size_t)grp * 1024 * 64; const bf16_t* Vg = (const bf16_t*)(ws + WS_VCMP) + (size_t)grp * 1024 * 64;
        const int nk = t0 / 16 + 1;
        const int tokl = 4 * wave + (r >> 2), tok = t0 + tokl, head = r & 3, hh = grp * 4 + head;
        bf16x8 qf[2]; { const bf16_t* qp = Q + (size_t)tok * 512 + hh * 64 + 8 * g; qf[0] = *(const bf16x8*)qp; qf[1] = *(const bf16x8*)(qp + 32); }
        __syncthreads();
        for (int i = tid; i < 32 * 256; i += NTHR) pslc[i] = 0.f;
        float m = -1e30f, l = 0.f;
        for (int kc = 0; kc < nk; kc += 128) {
            __syncthreads();
            for (int c = tid; c < 128 * 8; c += NTHR) { const int i = c >> 3, pc = c & 7; u32x4 kv = {0, 0, 0, 0};
                if (kc + i < 1024) kv = *(const u32x4*)(Kg + (size_t)(kc + i) * 64 + pc * 8);
                *(LAS u32x4*)(Kl + i * RP + pc * 16) = kv; }
            __syncthreads();
            const int nst = ((nk - kc) < 128 ? (nk - kc) : 128);
            for (int st = 0; st * 32 < nst; ++st) {
                const KFrag kf = load_kfrag(Kl + st * 32 * RP, lane);
                float s[8]; scores8(s, kf, qf);
                float mx = -1e30f; unsigned vm = 0;
#pragma unroll
                for (int e = 0; e < 8; ++e) { const int nn = kc + 32 * st + 8 * g + e; const bool ok = 16 * nn + 31 <= tok; vm |= ok ? (1u << e) : 0u; s[e] = ok ? s[e] * QK_SC : -1e30f; mx = fmaxf(mx, s[e]); }
                mx = rmax4(mx);
                const float mn = fmaxf(m, mx); float rs = 0.f;
#pragma unroll
                for (int e = 0; e < 8; ++e) rs += ((vm >> e) & 1u) ? fexp2(s[e] - mn) : 0.f;
                rs = rsum4(rs);
                l = l * fexp2(m - mn) + rs; m = mn;
            }
        }
        const float il = 1.0f / fmaxf(l, 1e-30f);
        f32x4 o[4];
#pragma unroll
        for (int c = 0; c < 4; ++c) o[c] = (f32x4){0.f, 0.f, 0.f, 0.f};
        for (int kc = 0; kc < nk; kc += 128) {
            __syncthreads();
            for (int c = tid; c < 128 * 8; c += NTHR) { const int i = c >> 3, pc = c & 7; u32x4 kv = {0, 0, 0, 0}, vv = {0, 0, 0, 0};
                if (kc + i < 1024) { kv = *(const u32x4*)(Kg + (size_t)(kc + i) * 64 + pc * 8); vv = *(const u32x4*)(Vg + (size_t)(kc + i) * 64 + pc * 8); }
                *(LAS u32x4*)(Kl + i * RP + pc * 16) = kv; *(LAS u32x4*)(Vl + i * RP + pc * 16) = vv; }
            __syncthreads();
            const int nst = ((nk - kc) < 128 ? (nk - kc) : 128);
            for (int st = 0; st * 32 < nst; ++st) {
                const KFrag kf = load_kfrag(Kl + st * 32 * RP, lane);
                bf16x8 vf[4]; load_vfrag(vf, Vl + st * 32 * RP, lane);
                float s[8]; scores8(s, kf, qf);
                float p[8];
#pragma unroll
                for (int e = 0; e < 8; ++e) { const int nn = kc + 32 * st + 8 * g + e; const bool ok = 16 * nn + 31 <= tok; p[e] = ok ? fexp2(s[e] * QK_SC - m) * il : 0.f; }
                const bf16x8 pf = pack8(p);
#pragma unroll
                for (int c = 0; c < 4; ++c) o[c] = mfma16(vf[c], pf, o[c]);
                float A = (p[0] + p[1]) + (p[2] + p[3]), B = p[3] + (p[4] + p[5]) + (p[6] + p[7]), C = p[7];
                A += __shfl_xor(A, 1); A += __shfl_xor(A, 2); B += __shfl_xor(B, 1); B += __shfl_xor(B, 2); C += __shfl_xor(C, 1); C += __shfl_xor(C, 2);
                if ((lane & 3) == 0) {
                    const int j0 = (kc + 32 * st) / 4 + 2 * g; float* pp = (float*)(pslc + tokl * 256);
                    atomicAdd(pp + j0, A);
                    if (j0 + 1 < 256) atomicAdd(pp + j0 + 1, B);
                    if (j0 + 2 < 256) atomicAdd(pp + j0 + 2, C);
                }
            }
        }
        { const float sc = GA[(size_t)tok * 24 + hh * 3 + 0];
#pragma unroll
          for (int c = 0; c < 4; ++c) { float* op = OA32 + (size_t)tok * 512 + hh * 64 + 16 * c + 4 * g; *(f32x4*)op = *(const f32x4*)op + o[c] * sc; } }
        __syncthreads();
        for (int tk = 0; tk < 4; ++tk) {
            const int tl = 4 * wave + tk, t = t0 + tl, cur = t >> 6;
            float v[4];
#pragma unroll
            for (int i = 0; i < 4; ++i) { const int j = lane + 64 * i; v[i] = (j > cur) ? -1.f : ((j == 0 || j == cur || j == cur - 1) ? 1e6f : pslc[tl * 256 + j]); }
            unsigned selb = 0;
            for (int it = 0; it < 16; ++it) {
                float bv = v[0]; int bi = 0;
#pragma unroll
                for (int i = 1; i < 4; ++i) if (v[i] > bv) { bv = v[i]; bi = i; }
                float wv = bv; int wj = lane + 64 * bi;
#pragma unroll
                for (int off = 32; off >= 1; off >>= 1) { const float ov = __shfl_xor(wv, off); const int oj = __shfl_xor(wj, off); if (ov > wv || (ov == wv && oj < wj)) { wv = ov; wj = oj; } }
                if (wv < 0.f) break;
                if ((wj & 63) == lane) { const int idx = wj >> 6; selb |= 1u << idx;
#pragma unroll
                    for (int i = 0; i < 4; ++i) if (i == idx) v[i] = -2.f; }
            }
#pragma unroll
            for (int i = 0; i < 4; ++i) { const unsigned long long bm = __ballot((selb >> i) & 1u);
                if (lane == 0) { SEL[((size_t)t * 2 + grp) * 8 + 2 * i] = (unsigned)bm; SEL[((size_t)t * 2 + grp) * 8 + 2 * i + 1] = (unsigned)(bm >> 32); } }
        }
    }
}

__device__ __forceinline__ void slc_phase(unsigned char* ws, LAS unsigned char* lds, int tid, int bid, int G) {
    const int lane = tid & 63, wave = tid >> 6, r = lane & 15, g = lane >> 4;
    const bf16_t* Q = (const bf16_t*)(ws + WS_QAT); const bf16_t* Kg = (const bf16_t*)(ws + WS_KS); const bf16_t* Vg = (const bf16_t*)(ws + WS_VS);
    const float* GA = (const float*)(ws + WS_GA); const float* OA32 = (const float*)(ws + WS_OA32); bf16_t* OA = (bf16_t*)(ws + WS_OA); const unsigned* SEL = (const unsigned*)(ws + WS_SEL);
    LAS unsigned* selm = (LAS unsigned*)(lds + 65536); LAS unsigned* uni = (LAS unsigned*)(lds + 65536 + 2048); LAS unsigned* blist = (LAS unsigned*)(lds + 65536 + 4096);
    for (int u = bid; u < 512; u += G) {
        const int tile = u >> 1, grp = u & 1, t0 = tile * 64, cur = tile;
        __syncthreads();
        selm[tid] = SEL[((size_t)(t0 + (tid >> 3)) * 2 + grp) * 8 + (tid & 7)];
        __syncthreads();
        if (tid < 8) { unsigned x = 0; for (int i = 0; i < 64; ++i) x |= selm[i * 8 + tid]; uni[tid] = x; }
        __syncthreads();
        if (tid < 256) {
            const int wq = tid >> 5; unsigned below = 0, total = 0;
#pragma unroll
            for (int w = 0; w < 8; ++w) { const unsigned x = uni[w]; const unsigned pc = __builtin_popcount(x); total += pc; below += (w < wq) ? pc : 0u; }
            const unsigned mine = uni[wq];
            if ((mine >> (tid & 31)) & 1u) blist[below + __builtin_popcount(mine & ((1u << (tid & 31)) - 1u))] = tid;
            if (tid == 0) blist[256] = total;
        }
        __syncthreads();
        const int nblk = __builtin_amdgcn_readfirstlane((int)blist[256]);
        const int tw = t0 + 8 * wave;
        bf16x8 qf[2][2]; float m[2], l[2]; f32x4 o[2][4];
#pragma unroll
        for (int qt = 0; qt < 2; ++qt) {
            const int tok = tw + 4 * qt + (r >> 2), head = r & 3;
            const bf16_t* qp = Q + (size_t)tok * 512 + (grp * 4 + head) * 64 + 8 * g;
            qf[qt][0] = *(const bf16x8*)qp; qf[qt][1] = *(const bf16x8*)(qp + 32);
            m[qt] = -1e30f; l[qt] = 0.f;
#pragma unroll
            for (int c = 0; c < 4; ++c) o[qt][c] = (f32x4){0.f, 0.f, 0.f, 0.f};
        }
        int bi = 0; int j = nblk > 0 ? __builtin_amdgcn_readfirstlane((int)blist[0]) : -1;
        const int srow = tid >> 3, spc = tid & 7;
        u32x4 kreg = {0, 0, 0, 0}, vreg = {0, 0, 0, 0};
        if (j >= 0) { const size_t off = (size_t)(64 * j + srow) * 128 + grp * 64 + spc * 8; kreg = *(const u32x4*)(Kg + off); vreg = *(const u32x4*)(Vg + off); }
        int buf = 0;
        *(LAS u32x4*)(lds + srow * RP + spc * 16) = kreg; *(LAS u32x4*)(lds + 64 * RP + srow * RP + spc * 16) = vreg;
        __syncthreads();
        while (j >= 0) {
            ++bi; const int jn = bi < nblk ? __builtin_amdgcn_readfirstlane((int)blist[bi]) : -1;
            if (jn >= 0) { const size_t off = (size_t)(64 * jn + srow) * 128 + grp * 64 + spc * 8; kreg = *(const u32x4*)(Kg + off); vreg = *(const u32x4*)(Vg + off); }
            LAS unsigned char* Kl = lds + buf * (128 * RP); LAS unsigned char* Vl = Kl + 64 * RP;
            unsigned bit[2];
#pragma unroll
            for (int qt = 0; qt < 2; ++qt) bit[qt] = (selm[(8 * wave + 4 * qt + (r >> 2)) * 8 + (j >> 5)] >> (j & 31)) & 1u;
            if (__ballot(bit[0] | bit[1]) != 0ull) {
#pragma unroll
                for (int st = 0; st < 2; ++st) {
                    const KFrag kf = load_kfrag(Kl + st * 32 * RP, lane);
                    bf16x8 vf[4]; load_vfrag(vf, Vl + st * 32 * RP, lane);
#pragma unroll
                    for (int qt = 0; qt < 2; ++qt) {
                        const int t = tw + 4 * qt + (r >> 2); unsigned vm = 0;
#pragma unroll
                        for (int e = 0; e < 8; ++e) { const int key = 64 * j + 32 * st + 8 * g + e; vm |= (bit[qt] && key <= t) ? (1u << e) : 0u; }
                        attn_tile_step(m[qt], l[qt], o[qt], qf[qt], kf, vf, vm);
                    }
                }
            }
            if (jn >= 0) { LAS unsigned char* Kn = lds + (buf ^ 1) * (128 * RP); *(LAS u32x4*)(Kn + srow * RP + spc * 16) = kreg; *(LAS u32x4*)(Kn + 64 * RP + srow * RP + spc * 16) = vreg; }
            __syncthreads();
            buf ^= 1; j = jn;
        }
#pragma unroll
        for (int qt = 0; qt < 2; ++qt) {
            const int tok = tw + 4 * qt + (r >> 2), head = r & 3, hh = grp * 4 + head;
            const float sc = GA[(size_t)tok * 24 + hh * 3 + 1] / fmaxf(l[qt], 1e-30f);
#pragma unroll
            for (int c = 0; c < 4; ++c) { const size_t off = (size_t)tok * 512 + hh * 64 + 16 * c + 4 * g; const f32x4 b = *(const f32x4*)(OA32 + off); const f32x4 v = b + o[qt][c] * sc;
                u32x2 w; w.x = pk2(v[0], v[1]); w.y = pk2(v[2], v[3]); *(u32x2*)(OA + off) = w; }
        }
    }
}

__device__ __forceinline__ ArgsP opqa() { ArgsP p = (ArgsP)__builtin_amdgcn_kernarg_segment_ptr(); asm volatile("" : "+s"(p)); return p; }
#ifndef MIX_MASK
#define MIX_MASK 0xff
#endif
__global__ void __launch_bounds__(NTHR, 2) fwd_kernel(Args a) {
    extern __shared__ __attribute__((aligned(16))) unsigned char lds_raw[];
    LAS unsigned char* lds = (LAS unsigned char*)lds_raw;
    cg::grid_group grid = cg::this_grid();
    const int tid0 = threadIdx.x, bid0 = blockIdx.x, G0 = gridDim.x;
    #define WSP ArgsP ap = opqa(); int tid = tid0, bid = bid0, G = G0; asm volatile("" : "+v"(tid), "+s"(bid), "+s"(G)); unsigned char* ws = ap->ws; bf16_t* XB = (bf16_t*)(ws + WS_XB); float* V32 = (float*)(ws + WS_V32); bf16_t* H = (bf16_t*)(ws + WS_H); (void)XB; (void)V32; (void)H;
#pragma unroll 1
    for (int l0 = 0; l0 < DEPTH; ++l0) {
        int l = l0; asm volatile("" : "+s"(l));
        { WSP prologue_phase(ap, l, lds, tid, bid, G); }
        grid.sync();
        { WSP pg8::Gemm g{XB, (const bf16_t*)(ws + W_GU1), S, 5632, 1024}; pg8::StaticOrder so; so.init(S, 5632, G, bid); EpiFfn e{H};
          pg8::gemm_phase<EpiFfn, pg8::StaticOrder, true, true>(lds, g, so, e); }
        grid.sync();
        { WSP pg8::Gemm g{H, (const bf16_t*)(ws + W_D1), S, 1024, FF}; pg8::StaticOrder so; so.init(S, 1024, G, bid); EpiRes e{l == 0 ? ap->in[0] : ap->out, V32, 0.5f};
          pg8::gemm_phase<EpiRes, pg8::StaticOrder, true, true>(lds, g, so, e); }
        grid.sync();
        { WSP ln_phase(V32, ap->in[1] + (size_t)l * 3 * D, ap->in[2] + (size_t)l * 3 * D, ap->out, XB, tid, bid, G); }
        grid.sync();
        { WSP pg8::Gemm g{XB, (const bf16_t*)(ws + W_IN), S, NZ, 1024}; pg8::StaticOrder so; so.init(S, NZ, G, bid); EpiZ e{ws};
          pg8::gemm_phase<EpiZ, pg8::StaticOrder, true, true>(lds, g, so, e); }
        grid.sync();
        { WSP cmp_mlp_phase(ws, lds, tid, bid, G); }
        { WSP sgu_phase(ap, ws, l, lds, tid, bid, G); }
        { WSP dil_phase(ws, lds, tid, bid, G); }
        { WSP win_phase(ws, lds, tid, bid, G); }
        grid.sync();
        { WSP dil_combine(ws, tid, bid, G); }
        { WSP cmp_attn_phase(ws, lds, tid, bid, G); }
        grid.sync();
        { WSP slc_phase(ws, lds, tid, bid, G); }
        grid.sync();
        { WSP pg8::Gemm g{(const bf16_t*)(ws + WS_OA), (const bf16_t*)(ws + W_A), S, 1024, 512}; pg8::StaticOrder so; so.init(S, 1024, G, bid); EpiGate e{(const bf16_t*)(ws + WS_GM), (float*)(ws + WS_M32), (bf16_t*)(ws + WS_MB), 0, 0};
          pg8::gemm_phase<EpiGate, pg8::StaticOrder, true, true>(lds, g, so, e); }
        { WSP pg8::Gemm g{(const bf16_t*)(ws + WS_OB), (const bf16_t*)(ws + W_B), S, 1024, 256}; pg8::StaticOrder so; so.init(S, 1024, G, bid); EpiGate e{(const bf16_t*)(ws + WS_GM), (float*)(ws + WS_M32), (bf16_t*)(ws + WS_MB), 1024, 1};
          pg8::gemm_phase<EpiGate, pg8::StaticOrder, true, true>(lds, g, so, e); }
        { WSP pg8::Gemm g{(const bf16_t*)(ws + WS_OC), (const bf16_t*)(ws + W_C), S, 1024, 512}; pg8::StaticOrder so; so.init(S, 1024, G, bid); EpiGate e{(const bf16_t*)(ws + WS_GM), (float*)(ws + WS_M32), (bf16_t*)(ws + WS_MB), 2048, 2};
          pg8::gemm_phase<EpiGate, pg8::StaticOrder, true, true>(lds, g, so, e); }
        grid.sync();
        { WSP pg8::Gemm g{(const bf16_t*)(ws + WS_MB), (const bf16_t*)(ws + W_O), S, 1024, 1024}; pg8::StaticOrder so; so.init(S, 1024, G, bid); EpiRes e{ap->out, V32, 1.0f};
          pg8::gemm_phase<EpiRes, pg8::StaticOrder, true, true>(lds, g, so, e); }
        grid.sync();
        { WSP ln_phase(V32, ap->in[1] + (size_t)l * 3 * D + D, ap->in[2] + (size_t)l * 3 * D + D, ap->out, XB, tid, bid, G); }
        grid.sync();
        { WSP pg8::Gemm g{XB, (const bf16_t*)(ws + W_GU2), S, 5632, 1024}; pg8::StaticOrder so; so.init(S, 5632, G, bid); EpiFfn e{H};
          pg8::gemm_phase<EpiFfn, pg8::StaticOrder, true, true>(lds, g, so, e); }
        grid.sync();
        { WSP pg8::Gemm g{H, (const bf16_t*)(ws + W_D2), S, 1024, FF}; pg8::StaticOrder so; so.init(S, 1024, G, bid); EpiRes e{ap->out, V32, 0.5f};
          pg8::gemm_phase<EpiRes, pg8::StaticOrder, true, true>(lds, g, so, e); }
        grid.sync();
        { WSP ln_phase(V32, ap->in[1] + (size_t)l * 3 * D + 2 * D, ap->in[2] + (size_t)l * 3 * D + 2 * D, ap->out, XB, tid, bid, G); }
        grid.sync();
    }
    #undef WSP
}

extern "C" void kernel_launch(void* const* d_in, const int* in_sizes, int n_in, void* d_out, int out_size, void* d_ws, size_t ws_size, hipStream_t stream) {
    static int grid = 0;
    if (grid == 0) {
        if (n_in != 24 || in_sizes[0] != S * D || out_size != S * D || ws_size < WS_END) { fprintf(stderr, "kernel_launch: unexpected shapes (n_in %d, in0 %d, out %d, ws %zu)\n", n_in, n_in > 0 ? in_sizes[0] : -1, out_size, ws_size); grid = -1; return; }
        int dev = 0, cus = 0, per_cu = 0;
        hipGetDevice(&dev); hipDeviceGetAttribute(&cus, hipDeviceAttributeMultiprocessorCount, dev);
        if (hipFuncSetAttribute((const void*)fwd_kernel, hipFuncAttributeMaxDynamicSharedMemorySize, LDS_BYTES) != hipSuccess) { fprintf(stderr, "kernel_launch: hipFuncSetAttribute failed\n"); grid = -1; return; }
        if (hipOccupancyMaxActiveBlocksPerMultiprocessor(&per_cu, (const void*)fwd_kernel, NTHR, LDS_BYTES) != hipSuccess || per_cu < 1) { fprintf(stderr, "kernel_launch: occupancy query gave %d\n", per_cu); per_cu = 1; }
        (void)hipGetLastError();
        grid = cus;
    }
    if (grid < 0) return;
    Args a{};
    for (int i = 0; i < 24; ++i) a.in[i] = (const float*)d_in[i];
    a.out = (float*)d_out; a.ws = (unsigned char*)d_ws;
    for (int d = 0; d < 32; ++d) { const float p = (float)pow(10000.0, (double)d / 32.0); a.inv[d] = 1.0f / p; }
    void* args[] = {&a};
    hipError_t e = hipLaunchCooperativeKernel((const void*)fwd_kernel, dim3(grid), dim3(NTHR), args, LDS_BYTES, stream);
    if (e != hipSuccess) fprintf(stderr, "cooperative launch failed: %s (grid %d)\n", hipGetErrorString(e), grid);
}
```

```cpp
#include <hip/hip_runtime.h>
#include <hip/hip_cooperative_groups.h>
#include <cstdio>
#include <cstdint>
#include <cmath>
namespace cg = cooperative_groups;
namespace pg8 {
#define PG8_LAS __attribute__((address_space(3)))
typedef unsigned short bf16_t;
typedef short bf16x8 __attribute__((ext_vector_type(8)));
typedef float f32x4 __attribute__((ext_vector_type(4)));
typedef unsigned u32x4 __attribute__((ext_vector_type(4)));
constexpr int BM = 256, BK = 64, HALF = 128, HTB = HALF * BK * 2  , STAGE_BYTES = 8 * HTB, NXCD = 8, WGM = 8;

__host__ __device__ __forceinline__ int lds_byte(int r, int c) { const int st = (r >> 4) * 2 + (c >> 5), rr = r & 15, cc = c & 31, ob = rr * 64 + cc * 2; return st * 1024 + (ob ^ (((ob >> 9) & 1) << 5)); }
__host__ __device__ __forceinline__ void stage_rc(int b, int& R, int& C) { const int st = b / 1024, sb = b % 1024, swz = sb ^ (((sb >> 9) & 1) << 5); R = (st >> 1) * 16 + swz / 64; C = (st & 1) * 32 + (swz % 64) / 2; }
__host__ __device__ __forceinline__ int perm32(int rho) { const int n = rho >> 4, i = rho & 15; return 8 * (i >> 2) + 4 * n + (i & 3); }

struct Unit { int pm, pn; };
struct Gemm { const bf16_t* A; const bf16_t* Bt; int M, N, K; };

struct StaticOrder {
    int nM, nN, nwg, G, c;
    __host__ __device__ void init(int M, int N, int G_, int c_) { nM = M / BM; nN = N / BM; nwg = nM * nN; G = G_; c = c_; }
    __host__ __device__ bool next(int i, Unit& u) const {
        const long L = (long)i * G + c; if (L >= nwg) return false;
        int wgid = (int)L; { const int q = nwg / NXCD, r = nwg % NXCD, xcd = wgid % NXCD, off = wgid / NXCD; wgid = (xcd < r ? xcd * (q + 1) : r * (q + 1) + (xcd - r) * q) + off; }
        const int nig = WGM * nN, gid = wgid / nig, fm = gid * WGM, gsz = (nM - fm) < WGM ? (nM - fm) : WGM;
        u.pm = fm + ((wgid % nig) % gsz); u.pn = (wgid % nig) / gsz; return true;
    }
    __device__ __forceinline__ void a_ready(const Unit&) const {}
    __device__ __forceinline__ void done(const Unit&) const {}
};

__device__ __forceinline__ unsigned cvt_pk_bf16(float lo, float hi) { unsigned r; asm volatile("v_cvt_pk_bf16_f32 %0, %1, %2" : "=v"(r) : "v"(lo), "v"(hi)); return r; }
typedef float f32x2 __attribute__((ext_vector_type(2)));
__device__ __forceinline__ f32x2 gelu_pk(f32x2 v) {
    const f32x2 av = __builtin_elementwise_abs(v), d = av * 0.2316418882f + 1.0f;
    f32x2 t; t.x = __builtin_amdgcn_rcpf(d.x); t.y = __builtin_amdgcn_rcpf(d.y);
    f32x2 q = t * 0.5307027145f + (-0.7265760135f); q = q * t + 0.7107068705f; q = q * t + (-0.142248368f); q = q * t + 0.127414796f; q = q * t;
    const f32x2 s = (v * v) * (-0.72134752044f);
    f32x2 e; e.x = __builtin_amdgcn_exp2f(s.x); e.y = __builtin_amdgcn_exp2f(s.y);
    const f32x2 m = v * (q * e), r = v - m;
    f32x2 o; o.x = v.x < 0.f ? m.x : r.x; o.y = v.y < 0.f ? m.y : r.y; return o;
}

template <int ACT  > struct EpiBf16 {
    static constexpr bool PERM = true, AFTER_DRAIN = false; static_assert(ACT == 0 || ACT == 1, "EpiBf16: ACT is 0 (none) or 1 (gelu_pk)");
    bf16_t* O; int ldc; const float* bias; int split_cols; size_t split_stride; float scale0;
    __device__ __forceinline__ void operator()(const f32x4 (&acc)[2][2][4][2], const Unit& u, int wr, int wc, int fr, int fq) const {
        const int row0 = u.pm * BM + wr * 64 + fr; int colt = u.pn * BM; bf16_t* base = O;
        float sc = 1.f; if (split_cols) { const int t = colt / split_cols; base += (size_t)t * split_stride; colt -= t * split_cols; if (t == 0) sc = scale0; }
        const int col0 = colt + wc * 32 + 8 * fq, bcol0 = u.pn * BM + wc * 32 + 8 * fq;
        f32x4 bv[2][2];
#pragma unroll
        for (int bj = 0; bj < 2; ++bj)
#pragma unroll
            for (int n = 0; n < 2; ++n) bv[bj][n] = bias ? *(const f32x4*)(bias + bcol0 + bj * HALF + 4 * n) : (f32x4){0.f, 0.f, 0.f, 0.f};
#pragma unroll
        for (int ai = 0; ai < 2; ++ai)
#pragma unroll
            for (int m = 0; m < 4; ++m) { bf16_t* rowp = base + (size_t)(row0 + ai * HALF + m * 16) * ldc + col0;
#pragma unroll
                for (int bj = 0; bj < 2; ++bj) { f32x4 v0 = acc[ai][bj][m][0] + bv[bj][0], v1 = acc[ai][bj][m][1] + bv[bj][1];
                    if (ACT == 1) { f32x2 a = gelu_pk((f32x2){v0[0], v0[1]}), b = gelu_pk((f32x2){v0[2], v0[3]}), c = gelu_pk((f32x2){v1[0], v1[1]}), d = gelu_pk((f32x2){v1[2], v1[3]});
                        v0 = (f32x4){a.x, a.y, b.x, b.y}; v1 = (f32x4){c.x, c.y, d.x, d.y}; }
                    v0 = v0 * sc; v1 = v1 * sc; u32x4 w; w.x = cvt_pk_bf16(v0[0], v0[1]); w.y = cvt_pk_bf16(v0[2], v0[3]); w.z = cvt_pk_bf16(v1[0], v1[1]); w.w = cvt_pk_bf16(v1[2], v1[3]);
                    *(u32x4*)(rowp + bj * HALF) = w; } }
    }
};


template <class Epi, class Sched, bool ALIGN_EPI = false, bool SP2 = false>
__device__ __forceinline__ void gemm_phase(PG8_LAS unsigned char* lds, const Gemm g, const Sched& S, const Epi& E) {
    int tid_ = threadIdx.x; asm volatile("" : "+v"(tid_)); const int tid = tid_, wid = __builtin_amdgcn_readfirstlane(tid >> 6), lane = tid & 63, wr = wid >> 2, wc = wid & 3, fr = lane & 15, fq = lane >> 4;
    const int K = g.K, nt = K / BK;
    unsigned voffA[2], voffB[2];
#pragma unroll
    for (int i = 0; i < 2; ++i) { int R, C; stage_rc(tid * 16 + i * 8192, R, C); const int Rb = Epi::PERM ? ((R & ~31) + perm32(R & 31)) : R;
        voffA[i] = (unsigned)(R * K + C) * 2u; voffB[i] = (unsigned)(Rb * K + C) * 2u; }
    const size_t kstep = (size_t)(BK * 2);
    const size_t hstep = (size_t)HALF * K * 2;
    const size_t tstep = 2 * hstep;
    const unsigned ldsw = (unsigned)wid * 1024u;
    const int aoff = lds_byte(wr * 64 + fr, fq * 8), boff = lds_byte(wc * 32 + fr, fq * 8);
#define PG8_SA(b, h) (((b) * 2 + (h)) * HTB)
#define PG8_SB(b, h) ((4 + (b) * 2 + (h)) * HTB)
#define PG8_STAGE(bufoff, gbase, voff) do { _Pragma("unroll") for (int _i = 0; _i < 2; ++_i) \
        __builtin_amdgcn_global_load_lds((const unsigned*)((const char*)(gbase) + (voff)[_i]), (PG8_LAS unsigned*)(lds + (bufoff) + ldsw + _i * 8192), 16, 0, 0); } while (0)
#define PG8_LDA(dst, b, h) do { _Pragma("unroll") for (int m = 0; m < 4; ++m) _Pragma("unroll") for (int k = 0; k < 2; ++k) dst[m][k] = *(const PG8_LAS bf16x8*)(lds + PG8_SA(b, h) + aoff + m * 2048 + k * 1024); } while (0)
#define PG8_LDB(dst, b, h) do { _Pragma("unroll") for (int n = 0; n < 2; ++n) _Pragma("unroll") for (int k = 0; k < 2; ++k) dst[n][k] = *(const PG8_LAS bf16x8*)(lds + PG8_SB(b, h) + boff + n * 2048 + k * 1024); } while (0)
#define PG8_MMA(ai, bj, At, Bt) do { __builtin_amdgcn_s_setprio(1); _Pragma("unroll") for (int m = 0; m < 4; ++m) _Pragma("unroll") for (int n = 0; n < 2; ++n) _Pragma("unroll") for (int k = 0; k < 2; ++k) \
        acc[ai][bj][m][n] = __builtin_amdgcn_mfma_f32_16x16x32_bf16(Bt[n][k], At[m][k], acc[ai][bj][m][n], 0, 0, 0); __builtin_amdgcn_s_setprio(0); } while (0)
#define PG8_WAIT_V(n) asm volatile("s_waitcnt vmcnt(" #n ")" ::: "memory")
#define PG8_WAIT_L(n) asm volatile("s_waitcnt lgkmcnt(" #n ")" ::: "memory")
#define PG8_BAR __builtin_amdgcn_s_barrier()
#define PG8_SCHED __builtin_amdgcn_sched_barrier(0)
    Unit cur, nxt; int ui = 0;
    if (!S.next(0, cur)) return;
    f32x4 acc[2][2][4][2];
#pragma unroll
    for (int a = 0; a < 2; ++a)
#pragma unroll
        for (int b = 0; b < 2; ++b)
#pragma unroll
            for (int m = 0; m < 4; ++m)
#pragma unroll
                for (int n = 0; n < 2; ++n) acc[a][b][m][n] = (f32x4){0.f, 0.f, 0.f, 0.f};
    bf16x8 At[4][2], B0[2][2], B1[2][2];
    const char* cA = (const char*)g.A + (size_t)cur.pm * tstep; const char* cB = (const char*)g.Bt + (size_t)cur.pn * tstep;
    S.a_ready(cur);
    if constexpr (SP2) {
        PG8_STAGE(PG8_SB(0, 0), cB, voffB); PG8_STAGE(PG8_SB(0, 1), cB + hstep, voffB); PG8_STAGE(PG8_SA(0, 0), cA, voffA); PG8_STAGE(PG8_SA(0, 1), cA + hstep, voffA);
        if (wr == 1) PG8_BAR;
        PG8_WAIT_V(2); PG8_BAR;
        PG8_STAGE(PG8_SB(1, 0), cB + kstep, voffB); PG8_STAGE(PG8_SA(1, 0), cA + kstep, voffA); PG8_STAGE(PG8_SB(1, 1), cB + hstep + kstep, voffB);
        PG8_WAIT_V(6); PG8_BAR;
    } else {
        PG8_STAGE(PG8_SB(0, 0), cB, voffB); PG8_STAGE(PG8_SA(0, 0), cA, voffA); PG8_STAGE(PG8_SB(0, 1), cB + hstep, voffB); PG8_STAGE(PG8_SA(0, 1), cA + hstep, voffA);
        if (wr == 1) PG8_BAR;
        PG8_WAIT_V(4); PG8_BAR;
        PG8_STAGE(PG8_SB(1, 0), cB + kstep, voffB); PG8_STAGE(PG8_SA(1, 0), cA + kstep, voffA); PG8_STAGE(PG8_SB(1, 1), cB + hstep + kstep, voffB);
        PG8_WAIT_V(6); PG8_BAR;
    }
    for (;;) {
        const bool has_next = S.next(ui + 1, nxt);
        const char* nA = has_next ? (const char*)g.A + (size_t)nxt.pm * tstep : cA; const char* nB = has_next ? (const char*)g.Bt + (size_t)nxt.pn * tstep : cB;
        for (int t = 0; t < nt; t += 2) {
            const bool last = (t == nt - 2);
            const char* a1 = cA + (size_t)(t + 1) * kstep;
            const char* a2 = last ? nA : cA + (size_t)(t + 2) * kstep; const char* b2 = last ? nB : cB + (size_t)(t + 2) * kstep;
            const char* a3 = a2 + kstep; const char* b3 = b2 + kstep;
            if (last && has_next) S.a_ready(nxt);
            if constexpr (SP2) {
            PG8_LDB(B0, 0, 0); PG8_LDB(B1, 0, 1); PG8_SCHED; PG8_LDA(At, 0, 0); PG8_STAGE(PG8_SA(1, 1), a1 + hstep, voffA);
            PG8_WAIT_V(8); PG8_WAIT_L(0); PG8_BAR; PG8_MMA(0, 0, At, B0); PG8_MMA(0, 1, At, B1); PG8_BAR; PG8_SCHED;
            PG8_LDA(At, 0, 1); PG8_STAGE(PG8_SB(0, 0), b2, voffB); PG8_STAGE(PG8_SB(0, 1), b2 + hstep, voffB); PG8_STAGE(PG8_SA(0, 0), a2, voffA);
            PG8_WAIT_V(8); PG8_WAIT_L(0); PG8_BAR; PG8_MMA(1, 0, At, B0); PG8_MMA(1, 1, At, B1); PG8_BAR; PG8_SCHED;
            PG8_LDB(B0, 1, 0); PG8_LDB(B1, 1, 1); PG8_SCHED; PG8_LDA(At, 1, 0); PG8_STAGE(PG8_SA(0, 1), a2 + hstep, voffA);
            PG8_WAIT_V(8); PG8_WAIT_L(0); PG8_BAR; PG8_MMA(0, 0, At, B0); PG8_MMA(0, 1, At, B1); PG8_BAR; PG8_SCHED;
            PG8_LDA(At, 1, 1); PG8_STAGE(PG8_SB(1, 0), b3, voffB); PG8_STAGE(PG8_SB(1, 1), b3 + hstep, voffB); PG8_STAGE(PG8_SA(1, 0), a3, voffA);
            PG8_WAIT_V(8); PG8_WAIT_L(0); PG8_BAR; PG8_MMA(1, 0, At, B0); PG8_MMA(1, 1, At, B1); PG8_BAR; PG8_SCHED;
            } else {
            PG8_LDB(B0, 0, 0); PG8_SCHED; PG8_LDA(At, 0, 0); PG8_STAGE(PG8_SA(1, 1), a1 + hstep, voffA);
            PG8_WAIT_L(8); PG8_BAR; PG8_WAIT_L(0); PG8_MMA(0, 0, At, B0); PG8_BAR; PG8_SCHED;
            PG8_LDB(B1, 0, 1); PG8_STAGE(PG8_SB(0, 0), b2, voffB);
            PG8_BAR; PG8_WAIT_L(0); PG8_MMA(0, 1, At, B1); PG8_BAR;
            PG8_LDA(At, 0, 1); PG8_STAGE(PG8_SA(0, 0), a2, voffA);
            PG8_BAR; PG8_WAIT_L(0); PG8_MMA(1, 0, At, B0); PG8_BAR; PG8_SCHED;
            PG8_STAGE(PG8_SB(0, 1), b2 + hstep, voffB);
            PG8_WAIT_V(6); PG8_BAR; PG8_MMA(1, 1, At, B1); PG8_BAR;
            PG8_LDB(B0, 1, 0); PG8_SCHED; PG8_LDA(At, 1, 0); PG8_STAGE(PG8_SA(0, 1), a2 + hstep, voffA);
            PG8_WAIT_L(8); PG8_BAR; PG8_WAIT_L(0); PG8_MMA(0, 0, At, B0); PG8_BAR; PG8_SCHED;
            PG8_LDB(B1, 1, 1); PG8_STAGE(PG8_SB(1, 0), b3, voffB);
            PG8_BAR; PG8_WAIT_L(0); PG8_MMA(0, 1, At, B1); PG8_BAR;
            PG8_LDA(At, 1, 1); PG8_STAGE(PG8_SA(1, 0), a3, voffA);
            PG8_BAR; PG8_WAIT_L(0); PG8_MMA(1, 0, At, B0); PG8_BAR; PG8_SCHED;
            PG8_STAGE(PG8_SB(1, 1), b3 + hstep, voffB);
            PG8_WAIT_V(6); PG8_BAR; PG8_MMA(1, 1, At, B1); PG8_BAR;
            }
        }
        if constexpr (ALIGN_EPI) { if (wr == 0) PG8_BAR; }
        if constexpr (!Epi::AFTER_DRAIN) { E(acc, cur, wr, wc, fr, fq); S.done(cur); }
        if (!has_next) break;
#pragma unroll
        for (int a = 0; a < 2; ++a)
#pragma unroll
            for (int b = 0; b < 2; ++b)
#pragma unroll
                for (int m = 0; m < 4; ++m)
#pragma unroll
                    for (int n = 0; n < 2; ++n) acc[a][b][m][n] = (f32x4){0.f, 0.f, 0.f, 0.f};
        cur = nxt; cA = nA; cB = nB; ++ui;
        if constexpr (ALIGN_EPI) { if (wr == 1) PG8_BAR; }
    }
    PG8_WAIT_V(0);
    if constexpr (!ALIGN_EPI) { if (wr == 0) PG8_BAR; }
    PG8_BAR;
    if constexpr (Epi::AFTER_DRAIN) { E.fused(acc, cur, wr, wc, fr, fq, lds, wid, lane); S.done(cur); }
#undef PG8_SA
#undef PG8_SB
#undef PG8_STAGE
#undef PG8_LDA
#undef PG8_LDB
#undef PG8_MMA
#undef PG8_WAIT_V
#undef PG8_WAIT_L
#undef PG8_BAR
#undef PG8_SCHED
}
}

#define LAS __attribute__((address_space(3)))
typedef unsigned short bf16_t;
typedef short bf16x8 __attribute__((ext_vector_type(8)));
typedef short s16x4 __attribute__((ext_vector_type(4)));
typedef short v4i16_t __attribute__((ext_vector_type(4)));
typedef float f32x4 __attribute__((ext_vector_type(4)));
typedef unsigned u32x4 __attribute__((ext_vector_type(4)));
typedef unsigned u32x2 __attribute__((ext_vector_type(2)));

constexpr int S = 16384, D = 1024, FF = 2816, DEPTH = 4, NZ = 7936, INC = 7704;
constexpr float ALPHA = 1.6817928305074292f;
constexpr float LN_EPS = 1e-5f;
constexpr float LOG2E = 1.4426950408889634f;
constexpr float QK_SC = 0.125f * LOG2E;
constexpr int NTHR = 512;
constexpr int LDS_BYTES = 155648;

constexpr size_t MiB = 1u << 20;
constexpr size_t W_GU1 = 1 * MiB;
constexpr size_t W_D1 = W_GU1 + (size_t)5632 * 1024 * 2;
constexpr size_t W_GU2 = W_D1 + (size_t)1024 * 2816 * 2;
constexpr size_t W_D2 = W_GU2 + (size_t)5632 * 1024 * 2;
constexpr size_t W_IN = W_D2 + (size_t)1024 * 2816 * 2;
constexpr size_t W_A = W_IN + (size_t)NZ * 1024 * 2;
constexpr size_t W_B = W_A + (size_t)1024 * 512 * 2;
constexpr size_t W_C = W_B + (size_t)1024 * 256 * 2;
constexpr size_t W_O = W_C + (size_t)1024 * 512 * 2;
constexpr size_t W_P1K = W_O + (size_t)1024 * 1024 * 2;
constexpr size_t W_P1V = W_P1K + (size_t)128 * 2048 * 2;
constexpr size_t W_P2K = W_P1V + (size_t)128 * 2048 * 2;
constexpr size_t W_P2V = W_P2K + (size_t)64 * 128 * 2;
constexpr size_t W_SGU = W_P2V + (size_t)64 * 128 * 2;
constexpr size_t W_PB = W_SGU + (size_t)4 * 128 * 128 * 2;
constexpr size_t W_END = W_PB + 2 * 128 * 4;
static_assert(W_END <= 57 * MiB, "weights region");
constexpr size_t WS_COS = 57 * MiB, WS_SIN = 59 * MiB;
constexpr size_t WS_XB = 61 * MiB;
constexpr size_t WS_V32 = 93 * MiB, WS_OA32 = WS_V32, WS_OA32B = WS_V32 + 32 * MiB;
constexpr size_t WS_H = 157 * MiB;
constexpr size_t WS_QAR = 157 * MiB, WS_QAT = 173 * MiB, WS_KS = 189 * MiB, WS_KW = 193 * MiB, WS_KC = 197 * MiB, WS_VC = 201 * MiB, WS_VS = 205 * MiB, WS_VW = 209 * MiB;
constexpr size_t WS_QB = 213 * MiB, WS_KB = 237 * MiB, WS_VB = 261 * MiB, WS_UVG = 285 * MiB, WS_GM = 317 * MiB, WS_GA = 413 * MiB;
constexpr size_t WS_M32 = 213 * MiB, WS_MB = 285 * MiB;
constexpr size_t WS_OA = 415 * MiB, WS_OB = 431 * MiB, WS_OC = 439 * MiB, WS_OD = 455 * MiB, WS_LSE = 479 * MiB, WS_SEL = 480 * MiB, WS_KCMP = 481 * MiB, WS_VCMP = 481 * MiB + 512 * 1024;
constexpr size_t WS_END = 482 * MiB;

struct Args { const float* in[24]; float* out; unsigned char* ws; float inv[32]; };
typedef const __attribute__((address_space(4))) Args* ArgsP;

__device__ __forceinline__ unsigned f2bf(float f) { unsigned u = __builtin_bit_cast(unsigned, f); return (u + 0x7fffu + ((u >> 16) & 1u)) >> 16; }
__device__ __forceinline__ unsigned pk2(float lo, float hi) { return pg8::cvt_pk_bf16(lo, hi); }
__device__ __forceinline__ float bf2f(unsigned short b) { return __builtin_bit_cast(float, (unsigned)b << 16); }
__device__ __forceinline__ float bflo(unsigned w) { return __builtin_bit_cast(float, w << 16); }
__device__ __forceinline__ float bfhi(unsigned w) { return __builtin_bit_cast(float, w & 0xffff0000u); }
__device__ __forceinline__ float fexp2(float x) { return __builtin_amdgcn_exp2f(x); }
__device__ __forceinline__ float frcp(float x) { return __builtin_amdgcn_rcpf(x); }
__device__ __forceinline__ float sigmoidf_(float x) { return frcp(1.0f + fexp2(-x * LOG2E)); }
__device__ __forceinline__ float siluf_(float x) { return x * sigmoidf_(x); }
__device__ __forceinline__ float gelu_tanh(float x) { const float u = 0.7978845608028654f * (x + 0.044715f * x * x * x); return x * frcp(1.0f + fexp2(-2.0f * LOG2E * u)); }
__device__ __forceinline__ float wave_sum(float v) {
#pragma unroll
    for (int o = 1; o < 64; o <<= 1) v += __shfl_xor(v, o);
    return v;
}
__device__ __forceinline__ f32x4 mfma16(bf16x8 a, bf16x8 b, f32x4 c) { return __builtin_amdgcn_mfma_f32_16x16x32_bf16(a, b, c, 0, 0, 0); }
__device__ __forceinline__ s16x4 tr_read(LAS const unsigned char* p) { return __builtin_bit_cast(s16x4, __builtin_amdgcn_ds_read_tr16_b64_v4i16((LAS v4i16_t*)p)); }
__device__ __forceinline__ bf16x8 cat8(s16x4 lo, s16x4 hi) { return (bf16x8){lo[0], lo[1], lo[2], lo[3], hi[0], hi[1], hi[2], hi[3]}; }
__device__ __forceinline__ bf16x8 pack8(const float (&p)[8]) {
    u32x4 w; w.x = pk2(p[0], p[1]); w.y = pk2(p[2], p[3]); w.z = pk2(p[4], p[5]); w.w = pk2(p[6], p[7]);
    return __builtin_bit_cast(bf16x8, w);
}

struct EpiFfn {
    static constexpr bool PERM = true, AFTER_DRAIN = false;
    bf16_t* H;
    __device__ __forceinline__ void operator()(const f32x4 (&acc)[2][2][4][2], const pg8::Unit& u, int wr, int wc, int fr, int fq) const {
        const int row0 = u.pm * 256 + wr * 64 + fr, col0 = u.pn * 128 + wc * 32 + 8 * fq;
#pragma unroll
        for (int ai = 0; ai < 2; ++ai)
#pragma unroll
            for (int m = 0; m < 4; ++m) {
                bf16_t* rowp = H + (size_t)(row0 + ai * 128 + m * 16) * FF + col0;
                float h[8];
#pragma unroll
                for (int n = 0; n < 2; ++n)
#pragma unroll
                    for (int i = 0; i < 4; ++i) h[4 * n + i] = siluf_(acc[ai][0][m][n][i]) * acc[ai][1][m][n][i];
                u32x4 w; w.x = pk2(h[0], h[1]); w.y = pk2(h[2], h[3]); w.z = pk2(h[4], h[5]); w.w = pk2(h[6], h[7]);
                *(u32x4*)rowp = w;
            }
    }
};
struct EpiRes {
    static constexpr bool PERM = false, AFTER_DRAIN = false;
    const float* X; float* V; float sc;
    __device__ __forceinline__ void operator()(const f32x4 (&acc)[2][2][4][2], const pg8::Unit& u, int wr, int wc, int fr, int fq) const {
        const int row0 = u.pm * 256 + wr * 64 + fr, col0 = u.pn * 256 + wc * 32 + 4 * fq;
#pragma unroll
        for (int ai = 0; ai < 2; ++ai)
#pragma unroll
            for (int m = 0; m < 4; ++m) {
                const size_t off = (size_t)(row0 + ai * 128 + m * 16) * D + col0;
#pragma unroll
                for (int bj = 0; bj < 2; ++bj)
#pragma unroll
                    for (int n = 0; n < 2; ++n) {
                        const f32x4 x = *(const f32x4*)(X + off + bj * 128 + n * 16);
                        *(f32x4*)(V + off + bj * 128 + n * 16) = x * ALPHA + acc[ai][bj][m][n] * sc;
                    }
            }
    }
};
struct EpiGate {
    static constexpr bool PERM = true, AFTER_DRAIN = false;
    const bf16_t* GM; float* M32; bf16_t* MB; int goff, mode;
    __device__ __forceinline__ void operator()(const f32x4 (&acc)[2][2][4][2], const pg8::Unit& u, int wr, int wc, int fr, int fq) const {
        const int row0 = u.pm * 256 + wr * 64 + fr, col0 = u.pn * 256 + wc * 32 + 8 * fq;
#pragma unroll
        for (int ai = 0; ai < 2; ++ai)
#pragma unroll
            for (int m = 0; m < 4; ++m) {
                const int row = row0 + ai * 128 + m * 16;
#pragma unroll
                for (int bj = 0; bj < 2; ++bj) {
                    const int col = col0 + bj * 128;
                    const u32x4 gw = *(const u32x4*)(GM + (size_t)row * 3072 + goff + col);
                    float v[8];
                    v[0] = bflo(gw.x) * acc[ai][bj][m][0][0]; v[1] = bfhi(gw.x) * acc[ai][bj][m][0][1]; v[2] = bflo(gw.y) * acc[ai][bj][m][0][2]; v[3] = bfhi(gw.y) * acc[ai][bj][m][0][3];
                    v[4] = bflo(gw.z) * acc[ai][bj][m][1][0]; v[5] = bfhi(gw.z) * acc[ai][bj][m][1][1]; v[6] = bflo(gw.w) * acc[ai][bj][m][1][2]; v[7] = bfhi(gw.w) * acc[ai][bj][m][1][3];
                    float* mp = M32 + (size_t)row * D + col;
                    if (mode != 0) { const f32x4 a = *(const f32x4*)mp, b = *(const f32x4*)(mp + 4); v[0] += a[0]; v[1] += a[1]; v[2] += a[2]; v[3] += a[3]; v[4] += b[0]; v[5] += b[1]; v[6] += b[2]; v[7] += b[3]; }
                    if (mode != 2) { *(f32x4*)mp = (f32x4){v[0], v[1], v[2], v[3]}; *(f32x4*)(mp + 4) = (f32x4){v[4], v[5], v[6], v[7]}; }
                    else { u32x4 w; w.x = pk2(v[0], v[1]); w.y = pk2(v[2], v[3]); w.z = pk2(v[4], v[5]); w.w = pk2(v[6], v[7]); *(u32x4*)(MB + (size_t)row * D + col) = w; }
                }
            }
    }
};
struct EpiZ {
    static constexpr bool PERM = true, AFTER_DRAIN = false;
    unsigned char* ws;
    __device__ __forceinline__ void operator()(const f32x4 (&acc)[2][2][4][2], const pg8::Unit& u, int wr, int wc, int fr, int fq) const {
        const int pn = u.pn, row0 = u.pm * 256 + wr * 64 + fr;
        if (pn <= 8) {
            bf16_t* dst; bf16_t* raw = nullptr; int ld, hcol;
            if (pn <= 1) { dst = (bf16_t*)(ws + WS_QAT); raw = (bf16_t*)(ws + WS_QAR); ld = 512; hcol = (pn * 4 + wc) * 64; }
            else if (pn == 2) { dst = (bf16_t*)(ws + (wc < 2 ? WS_KS : WS_KW)); ld = 128; hcol = (wc & 1) * 64; }
            else if (pn <= 5) { dst = (bf16_t*)(ws + WS_QB); ld = 768; hcol = ((pn - 3) * 4 + wc) * 64; }
            else { dst = (bf16_t*)(ws + WS_KB); ld = 768; hcol = ((pn - 6) * 4 + wc) * 64; }
            const float* ct = (const float*)(ws + WS_COS); const float* st = (const float*)(ws + WS_SIN);
#pragma unroll
            for (int ai = 0; ai < 2; ++ai)
#pragma unroll
                for (int m = 0; m < 4; ++m) {
                    const int row = row0 + ai * 128 + m * 16;
                    const f32x4 c0 = *(const f32x4*)(ct + row * 32 + 8 * fq), c1 = *(const f32x4*)(ct + row * 32 + 8 * fq + 4);
                    const f32x4 s0 = *(const f32x4*)(st + row * 32 + 8 * fq), s1 = *(const f32x4*)(st + row * 32 + 8 * fq + 4);
                    const f32x4 a0 = acc[ai][0][m][0], a1 = acc[ai][0][m][1], b0 = acc[ai][1][m][0], b1 = acc[ai][1][m][1];
                    const f32x4 o10 = a0 * c0 - b0 * s0, o11 = a1 * c1 - b1 * s1, o20 = b0 * c0 + a0 * s0, o21 = b1 * c1 + a1 * s1;
                    bf16_t* p = dst + (size_t)row * ld + hcol + 8 * fq;
                    u32x4 w; w.x = pk2(o10[0], o10[1]); w.y = pk2(o10[2], o10[3]); w.z = pk2(o11[0], o11[1]); w.w = pk2(o11[2], o11[3]); *(u32x4*)p = w;
                    w.x = pk2(o20[0], o20[1]); w.y = pk2(o20[2], o20[3]); w.z = pk2(o21[0], o21[1]); w.w = pk2(o21[2], o21[3]); *(u32x4*)(p + 32) = w;
                    if (raw) { bf16_t* q = raw + (size_t)row * ld + hcol + 8 * fq;
                        w.x = pk2(a0[0], a0[1]); w.y = pk2(a0[2], a0[3]); w.z = pk2(a1[0], a1[1]); w.w = pk2(a1[2], a1[3]); *(u32x4*)q = w;
                        w.x = pk2(b0[0], b0[1]); w.y = pk2(b0[2], b0[3]); w.z = pk2(b1[0], b1[1]); w.w = pk2(b1[2], b1[3]); *(u32x4*)(q + 32) = w; }
                }
        } else if (pn <= 29) {
            const int act = pn <= 13 ? 0 : (pn <= 17 ? 1 : 2);
#pragma unroll
            for (int bj = 0; bj < 2; ++bj) {
                bf16_t* dst; int ld, c0;
                if (pn == 9) { dst = (bf16_t*)(ws + (bj ? WS_VC : WS_KC)); ld = 128; c0 = 0; }
                else if (pn == 10) { dst = (bf16_t*)(ws + (bj ? WS_VW : WS_VS)); ld = 128; c0 = 0; }
                else if (pn <= 13) { dst = (bf16_t*)(ws + WS_VB); ld = 768; c0 = (pn - 11) * 256 + bj * 128; }
                else if (pn <= 17) { dst = (bf16_t*)(ws + WS_UVG); ld = 1024; c0 = (pn - 14) * 256 + bj * 128; }
                else { dst = (bf16_t*)(ws + WS_GM); ld = 3072; c0 = (pn - 18) * 256 + bj * 128; }
                c0 += wc * 32 + 8 * fq;
#pragma unroll
                for (int ai = 0; ai < 2; ++ai)
#pragma unroll
                    for (int m = 0; m < 4; ++m) {
                        const int row = row0 + ai * 128 + m * 16;
                        float v[8];
#pragma unroll
                        for (int n = 0; n < 2; ++n)
#pragma unroll
                            for (int i = 0; i < 4; ++i) { const float x = acc[ai][bj][m][n][i]; v[4 * n + i] = act == 0 ? x : (act == 1 ? gelu_tanh(x) : sigmoidf_(x)); }
                        u32x4 w; w.x = pk2(v[0], v[1]); w.y = pk2(v[2], v[3]); w.z = pk2(v[4], v[5]); w.w = pk2(v[6], v[7]);
                        *(u32x4*)(dst + (size_t)row * ld + c0) = w;
                    }
            }
        } else {
            if (wc == 0 && fq < 3) {
                float* ga = (float*)(ws + WS_GA);
#pragma unroll
                for (int ai = 0; ai < 2; ++ai)
#pragma unroll
                    for (int m = 0; m < 4; ++m) {
                        const int row = row0 + ai * 128 + m * 16;
#pragma unroll
                        for (int n = 0; n < 2; ++n) { const f32x4 x = acc[ai][0][m][n];
                            *(f32x4*)(ga + (size_t)row * 24 + 8 * fq + 4 * n) = (f32x4){sigmoidf_(x[0]), sigmoidf_(x[1]), sigmoidf_(x[2]), sigmoidf_(x[3])}; }
                    }
            }
        }
    }
};

__device__ __forceinline__ int win_col0(int dg) {
    const int pn = dg >> 3, q = dg & 7, hs = q & 3, half = q >> 2;
    if (pn <= 1) return (pn * 4 + hs) * 64 + 32 * half;
    if (pn == 2) return (hs == 0 ? 768 : hs == 1 ? 832 : hs == 2 ? 1024 : 1088) + 32 * half;
    if (pn <= 5) return 1304 + ((pn - 3) * 4 + hs) * 64 + 32 * half;
    if (pn <= 8) return 2072 + ((pn - 6) * 4 + hs) * 64 + 32 * half;
    if (pn == 9) return (q < 4 ? 512 : 640) + 32 * (q & 3);
    if (pn == 10) return (q < 4 ? 896 : 1152) + 32 * (q & 3);
    if (pn <= 13) return 2840 + (pn - 11) * 256 + 32 * q;
    if (pn <= 17) return 3608 + (pn - 14) * 256 + 32 * q;
    if (pn <= 29) return 4632 + (pn - 18) * 256 + 32 * q;
    return q == 0 ? 1280 : -1;
}

__device__ __forceinline__ void transpose_item(const float* W, int ldw, int col0, int k0, bf16_t* dst, int K, LAS float* scr, int lane) {
    if (col0 >= 0) {
#pragma unroll 8
        for (int i = 0; i < 32; ++i) { const int kk = 2 * i + (lane >> 5); scr[kk * 33 + (lane & 31)] = W[(size_t)(k0 + kk) * ldw + col0 + (lane & 31)]; }
    } else {
#pragma unroll 8
        for (int i = 0; i < 32; ++i) { const int kk = 2 * i + (lane >> 5); scr[kk * 33 + (lane & 31)] = 0.f; }
    }
    asm volatile("s_waitcnt lgkmcnt(0)" ::: "memory");
    const int c = lane & 7;
#pragma unroll
    for (int j = 0; j < 4; ++j) { const int n = (lane >> 3) + 8 * j; const LAS float* s = scr + (8 * c) * 33 + n;
        u32x4 o; o.x = pk2(s[0 * 33], s[1 * 33]); o.y = pk2(s[2 * 33], s[3 * 33]); o.z = pk2(s[4 * 33], s[5 * 33]); o.w = pk2(s[6 * 33], s[7 * 33]);
        *(u32x4*)(dst + (size_t)n * K + 8 * c) = o; }
    asm volatile("s_waitcnt lgkmcnt(0)" ::: "memory");
}

__device__ __forceinline__ void prologue_phase(ArgsP a, int l, LAS unsigned char* lds, int tid, int bid, int G) {
    const int lane = tid & 63, wave = tid >> 6;
    LAS float* scr = (LAS float*)(lds + wave * 16384);
    unsigned char* ws = a->ws;
    const int gw = bid * 8 + wave, NGW = G * 8;
    const float* g1 = a->in[3] + (size_t)l * D * FF; const float* u1 = a->in[4] + (size_t)l * D * FF; const float* d1 = a->in[5] + (size_t)l * FF * D;
    const float* g2 = a->in[6] + (size_t)l * D * FF; const float* u2 = a->in[7] + (size_t)l * D * FF; const float* d2 = a->in[8] + (size_t)l * FF * D;
    const float* win = a->in[9] + (size_t)l * D * INC;
    const float* pkw1 = a->in[11] + (size_t)l * 2048 * 128; const float* pkw2 = a->in[12] + (size_t)l * 128 * 64;
    const float* pvw1 = a->in[14] + (size_t)l * 2048 * 128; const float* pvw2 = a->in[15] + (size_t)l * 128 * 64;
    const float* wa = a->in[20] + (size_t)l * 512 * D; const float* wb = a->in[21] + (size_t)l * 256 * D; const float* wc = a->in[22] + (size_t)l * 512 * D; const float* wo = a->in[23] + (size_t)l * D * D;
    constexpr int I_GU = 16 * 176, I_D = 44 * 32, I_IN = 16 * 248, I_A = 8 * 32, I_B = 4 * 32, I_O = 16 * 32, I_P1 = 32 * 4, I_P2 = 2 * 2;
    constexpr int NIT = 2 * I_GU + 2 * I_D + I_IN + 2 * I_A + I_B + I_O + 2 * I_P1 + 2 * I_P2;
    for (int it = gw; it < NIT; it += NGW) {
        int r = it; const float* src; int ldw, col0, kb, dg, K; size_t dbase;
        if (r < 2 * I_GU) { const int f = r >= I_GU; if (f) r -= I_GU; kb = r / 176; dg = r % 176; const int pn = dg >> 3, q = dg & 7;
            src = (q < 4) ? (f ? g2 : g1) : (f ? u2 : u1); ldw = FF; col0 = 128 * pn + 32 * (q & 3); K = 1024; dbase = f ? W_GU2 : W_GU1; }
        else if ((r -= 2 * I_GU) < 2 * I_D) { const int f = r >= I_D; if (f) r -= I_D; kb = r / 32; dg = r % 32; src = f ? d2 : d1; ldw = D; col0 = 32 * dg; K = FF; dbase = f ? W_D2 : W_D1; }
        else if ((r -= 2 * I_D) < I_IN) { kb = r / 248; dg = r % 248; src = win; ldw = INC; col0 = win_col0(dg); K = 1024; dbase = W_IN; }
        else if ((r -= I_IN) < I_A) { kb = r / 32; dg = r % 32; src = wa; ldw = D; col0 = 32 * dg; K = 512; dbase = W_A; }
        else if ((r -= I_A) < I_A) { kb = r / 32; dg = r % 32; src = wc; ldw = D; col0 = 32 * dg; K = 512; dbase = W_C; }
        else if ((r -= I_A) < I_B) { kb = r / 32; dg = r % 32; src = wb; ldw = D; col0 = 32 * dg; K = 256; dbase = W_B; }
        else if ((r -= I_B) < I_O) { kb = r / 32; dg = r % 32; src = wo; ldw = D; col0 = 32 * dg; K = 1024; dbase = W_O; }
        else if ((r -= I_O) < 2 * I_P1) { const int f = r >= I_P1; if (f) r -= I_P1; kb = r / 4; dg = r % 4; src = f ? pvw1 : pkw1; ldw = 128; col0 = 32 * dg; K = 2048; dbase = f ? W_P1V : W_P1K; }
        else { r -= 2 * I_P1; const int f = r >= I_P2; if (f) r -= I_P2; kb = r / 2; dg = r % 2; src = f ? pvw2 : pkw2; ldw = 64; col0 = 32 * dg; K = 128; dbase = f ? W_P2V : W_P2K; }
        transpose_item(src, ldw, col0, kb * 64, (bf16_t*)(ws + dbase) + (size_t)dg * 32 * K + kb * 64, K, scr, lane);
    }
    { const float* sw = a->in[18] + (size_t)l * 4 * 128 * 128; bf16_t* o = (bf16_t*)(ws + W_SGU);
      for (int i = bid * NTHR + tid; i < 4 * 128 * 128; i += G * NTHR) { const int t = (i >> 7) & 127, s = i & 127; o[i] = (bf16_t)f2bf(s <= t ? sw[i] : 0.f); } }
    for (int o = gw; o < 256; o += NGW) {
        const int which = o >> 7, c = o & 127;
        const float* pos = a->in[which ? 13 : 10] + (size_t)l * 2048; const float* w1 = which ? pvw1 : pkw1;
        float s = 0.f;
        for (int kk = lane; kk < 2048; kk += 64) s += pos[kk] * w1[(size_t)kk * 128 + c];
        s = wave_sum(s);
        if (lane == 0) ((float*)(ws + W_PB))[o] = s;
    }
    if (l == 0) {
        const f32x4* x4 = (const f32x4*)a->in[0]; u32x2* xb = (u32x2*)(ws + WS_XB);
        for (size_t i = (size_t)bid * NTHR + tid; i < (size_t)S * D / 4; i += (size_t)G * NTHR) { const f32x4 v = x4[i]; u32x2 w; w.x = pk2(v[0], v[1]); w.y = pk2(v[2], v[3]); xb[i] = w; }
        float* ct = (float*)(ws + WS_COS); float* st = (float*)(ws + WS_SIN);
        for (int i = bid * NTHR + tid; i < S * 32; i += G * NTHR) {
            const int t = i >> 5, d = i & 31;
            const float angf = (float)t * a->inv[d];
            const double ang = (double)angf;
            const double kq = rint(ang * 0.63661977236758134308);
            const double rr = (ang - kq * 1.57079632673412561417) - kq * 6.07710050650619224932e-11;
            const double r2 = rr * rr;
#define DC(x) ([](double v_) { asm volatile("" : "+s"(v_)); return v_; }(x))
            double sn = DC(1.0 / 6227020800.0); sn = sn * r2 + DC(-1.0 / 39916800); sn = sn * r2 + DC(1.0 / 362880); sn = sn * r2 + DC(-1.0 / 5040); sn = sn * r2 + DC(1.0 / 120); sn = sn * r2 + DC(-1.0 / 6); sn = rr + rr * r2 * sn;
            double cs = DC(-1.0 / 87178291200.0); cs = cs * r2 + DC(1.0 / 479001600); cs = cs * r2 + DC(-1.0 / 3628800); cs = cs * r2 + DC(1.0 / 40320); cs = cs * r2 + DC(-1.0 / 720); cs = cs * r2 + DC(1.0 / 24); cs = cs * r2 + DC(-0.5); cs = 1.0 + r2 * cs;
#undef DC
            const int qd = ((int)kq) & 3;
            const double c = qd == 0 ? cs : qd == 1 ? -sn : qd == 2 ? -cs : sn;
            const double s = qd == 0 ? sn : qd == 1 ? cs : qd == 2 ? -sn : -cs;
            ct[i] = (float)c; st[i] = (float)s;
        }
    }
}

__device__ __forceinline__ void ln_phase(const float* V, const float* gam, const float* bet, float* X, bf16_t* XB, int tid, int bid, int G) {
    const int lane = tid & 63, wave = tid >> 6;
    const int gw = bid * 8 + wave, NGW = G * 8;
    f32x4 gv[4], bv[4];
#pragma unroll
    for (int j = 0; j < 4; ++j) { gv[j] = ((const f32x4*)gam)[64 * j + lane]; bv[j] = ((const f32x4*)bet)[64 * j + lane]; }
    for (int m = gw; m < S; m += NGW) {
        const f32x4* xr = (const f32x4*)(V + (size_t)m * D) + lane;
        f32x4 v[4]; float s = 0.f;
#pragma unroll
        for (int j = 0; j < 4; ++j) { v[j] = xr[64 * j]; s += (v[j][0] + v[j][1]) + (v[j][2] + v[j][3]); }
        const float mean = wave_sum(s) * (1.f / D); float s2 = 0.f;
#pragma unroll
        for (int j = 0; j < 4; ++j) { v[j] = v[j] - mean; s2 += (v[j][0] * v[j][0] + v[j][1] * v[j][1]) + (v[j][2] * v[j][2] + v[j][3] * v[j][3]); }
        const float rstd = 1.0f / sqrtf(wave_sum(s2) * (1.f / D) + LN_EPS);
        f32x4* xo = (f32x4*)(X + (size_t)m * D) + lane; u32x2* bo = (u32x2*)(XB + (size_t)m * D) + lane;
#pragma unroll
        for (int j = 0; j < 4; ++j) { const f32x4 y = v[j] * rstd * gv[j] + bv[j]; xo[64 * j] = y; u32x2 w; w.x = pk2(y[0], y[1]); w.y = pk2(y[2], y[3]); bo[64 * j] = w; }
    }
}

constexpr int RP = 144;
struct KFrag { bf16x8 a0, a1, b0, b1; };
__device__ __forceinline__ KFrag load_kfrag(LAS const unsigned char* Kt, int lane) {
    const int r = lane & 15, g = lane >> 4;
    LAS const unsigned char* ka = Kt + (8 * (r >> 2) + (r & 3)) * RP + g * 16;
    KFrag k; k.a0 = *(LAS const bf16x8*)ka; k.a1 = *(LAS const bf16x8*)(ka + 64); k.b0 = *(LAS const bf16x8*)(ka + 4 * RP); k.b1 = *(LAS const bf16x8*)(ka + 4 * RP + 64);
    return k;
}
__device__ __forceinline__ void load_vfrag(bf16x8 (&vf)[4], LAS const unsigned char* Vt, int lane) {
    const int r = lane & 15, g = lane >> 4;
    LAS const unsigned char* vb = Vt + (8 * g + (r >> 2)) * RP + (lane & 3) * 8;
#pragma unroll
    for (int c = 0; c < 4; ++c) vf[c] = cat8(tr_read(vb + c * 32), tr_read(vb + 4 * RP + c * 32));
}
__device__ __forceinline__ void scores8(float (&s)[8], const KFrag& k, const bf16x8 (&qf)[2]) {
    const f32x4 z = {0.f, 0.f, 0.f, 0.f};
    f32x4 sa = mfma16(k.a0, qf[0], z); sa = mfma16(k.a1, qf[1], sa);
    f32x4 sb = mfma16(k.b0, qf[0], z); sb = mfma16(k.b1, qf[1], sb);
    s[0] = sa[0]; s[1] = sa[1]; s[2] = sa[2]; s[3] = sa[3]; s[4] = sb[0]; s[5] = sb[1]; s[6] = sb[2]; s[7] = sb[3];
}
__device__ __forceinline__ float rmax4(float v) { v = fmaxf(v, __shfl_xor(v, 16)); return fmaxf(v, __shfl_xor(v, 32)); }
__device__ __forceinline__ float rsum4(float v) { v += __shfl_xor(v, 16); return v + __shfl_xor(v, 32); }

__device__ __forceinline__ void attn_tile_step(float& m, float& l, f32x4 (&o)[4], const bf16x8 (&qf)[2], const KFrag& k, const bf16x8 (&vf)[4], unsigned vmask) {
    float s[8]; scores8(s, k, qf);
    float mx = -1e30f;
#pragma unroll
    for (int e = 0; e < 8; ++e) { s[e] = ((vmask >> e) & 1u) ? s[e] * QK_SC : -1e30f; mx = fmaxf(mx, s[e]); }
    mx = rmax4(mx);
    const float mn = fmaxf(m, mx), corr = fexp2(m - mn);
    float p[8], rs = 0.f;
#pragma unroll
    for (int e = 0; e < 8; ++e) { p[e] = ((vmask >> e) & 1u) ? fexp2(s[e] - mn) : 0.f; rs += p[e]; }
    rs = rsum4(rs);
    l = l * corr + rs; m = mn;
    const bf16x8 pf = pack8(p);
#pragma unroll
    for (int c = 0; c < 4; ++c) { o[c] = o[c] * corr; o[c] = mfma16(vf[c], pf, o[c]); }
}

__device__ __forceinline__ void win_phase(unsigned char* ws, LAS unsigned char* lds, int tid, int bid, int G) {
    const int lane = tid & 63, wave = tid >> 6, r = lane & 15, g = lane >> 4;
    const bf16_t* Q = (const bf16_t*)(ws + WS_QAT); const bf16_t* Kg = (const bf16_t*)(ws + WS_KW); const bf16_t* Vg = (const bf16_t*)(ws + WS_VW);
    const float* GA = (const float*)(ws + WS_GA); float* OA32 = (float*)(ws + WS_OA32);
    LAS unsigned char* Kl = lds; LAS unsigned char* Vl = lds + 128 * RP;
    for (int u = bid; u < 512; u += G) {
        const int tile = u >> 1, grp = u & 1, t0 = tile * 64;
        const int kstart = t0 >= 512 ? t0 - 512 : 0, kend = t0 + 64;
        const int tw = t0 + 8 * wave;
        bf16x8 qf[2][2]; float m[2], l[2]; f32x4 o[2][4];
#pragma unroll
        for (int qt = 0; qt < 2; ++qt) {
            const int tok = tw + 4 * qt + (r >> 2), head = r & 3;
            const bf16_t* qp = Q + (size_t)tok * 512 + (grp * 4 + head) * 64 + 8 * g;
            qf[qt][0] = *(const bf16x8*)qp; qf[qt][1] = *(const bf16x8*)(qp + 32);
            m[qt] = -1e30f; l[qt] = 0.f;
#pragma unroll
            for (int c = 0; c < 4; ++c) o[qt][c] = (f32x4){0.f, 0.f, 0.f, 0.f};
        }
        for (int kc = kstart; kc < kend; kc += 128) {
            const int nrows = (kend - kc) < 128 ? (kend - kc) : 128;
            __syncthreads();
            for (int c = tid; c < nrows * 8; c += NTHR) { const int i = c >> 3, pc = c & 7;
                *(LAS u32x4*)(Kl + i * RP + pc * 16) = *(const u32x4*)(Kg + (size_t)(kc + i) * 128 + grp * 64 + pc * 8);
                *(LAS u32x4*)(Vl + i * RP + pc * 16) = *(const u32x4*)(Vg + (size_t)(kc + i) * 128 + grp * 64 + pc * 8); }
            __syncthreads();
            for (int st = 0; st < nrows / 32; ++st) {
                const int k0 = kc + 32 * st;
                if (k0 + 31 < tw - 511 || k0 > tw + 7) continue;
                const KFrag kf = load_kfrag(Kl + st * 32 * RP, lane);
                bf16x8 vf[4]; load_vfrag(vf, Vl + st * 32 * RP, lane);
#pragma unroll
                for (int qt = 0; qt < 2; ++qt) {
                    const int t = tw + 4 * qt + (r >> 2); unsigned vm = 0;
#pragma unroll
                    for (int e = 0; e < 8; ++e) { const int dlt = t - (k0 + 8 * g + e); vm |= (dlt >= 0 && dlt < 512) ? (1u << e) : 0u; }
                    attn_tile_step(m[qt], l[qt], o[qt], qf[qt], kf, vf, vm);
                }
            }
        }
#pragma unroll
        for (int qt = 0; qt < 2; ++qt) {
            const int tok = tw + 4 * qt + (r >> 2), head = r & 3, hh = grp * 4 + head;
            const float sc = GA[(size_t)tok * 24 + hh * 3 + 2] / fmaxf(l[qt], 1e-30f);
#pragma unroll
            for (int c = 0; c < 4; ++c) *(f32x4*)(OA32 + (size_t)tok * 512 + hh * 64 + 16 * c + 4 * g) = o[qt][c] * sc;
        }
    }
}

__device__ __forceinline__ void dil_phase(unsigned char* ws, LAS unsigned char* lds, int tid, int bid, int G) {
    const int lane = tid & 63, wave = tid >> 6, r = lane & 15, g = lane >> 4;
    const bf16_t* Q = (const bf16_t*)(ws + WS_QB); const bf16_t* Kg = (const bf16_t*)(ws + WS_KB); const bf16_t* Vg = (const bf16_t*)(ws + WS_VB);
    bf16_t* OD = (bf16_t*)(ws + WS_OD); float* LSE = (float*)(ws + WS_LSE);
    LAS unsigned char* Kl = lds; LAS unsigned char* Vl = lds + 256 * RP;
    for (int u = bid; u < 1536; u += G) {
        const int h = u >> 7, rem = u & 127, gi = h >> 2, hi = h & 3, dil = 1 << (2 * gi), nsub = 128 >> (2 * gi), rr = rem / nsub, n = rem % nsub;
        const int mbase = 128 * n - 128;
        __syncthreads();
        for (int c = tid; c < 256 * 8; c += NTHR) { const int i = c >> 3, pc = c & 7; const int mk = mbase + i;
            u32x4 kv = {0, 0, 0, 0}, vv = {0, 0, 0, 0};
            if (mk >= 0) { const size_t off = (size_t)(mk * dil + rr) * 768 + h * 64 + pc * 8; kv = *(const u32x4*)(Kg + off); vv = *(const u32x4*)(Vg + off); }
            *(LAS u32x4*)(Kl + i * RP + pc * 16) = kv; *(LAS u32x4*)(Vl + i * RP + pc * 16) = vv; }
        __syncthreads();
        const int mq = 128 * n + 16 * wave + r, tq = mq * dil + rr;
        bf16x8 qf[2]; { const bf16_t* qp = Q + (size_t)tq * 768 + h * 64 + 8 * g; qf[0] = *(const bf16x8*)qp; qf[1] = *(const bf16x8*)(qp + 32); }
        float m = -1e30f, l = 0.f; f32x4 o[4];
#pragma unroll
        for (int c = 0; c < 4; ++c) o[c] = (f32x4){0.f, 0.f, 0.f, 0.f};
        const int start = (16 * wave) & ~31;
        for (int st = 0; st < 5; ++st) {
            const int i0 = start + 32 * st;
            const KFrag kf = load_kfrag(Kl + i0 * RP, lane);
            bf16x8 vf[4]; load_vfrag(vf, Vl + i0 * RP, lane);
            unsigned vm = 0;
#pragma unroll
            for (int e = 0; e < 8; ++e) { const int mk = mbase + i0 + 8 * g + e; const int dlt = mq - mk; vm |= (dlt >= 0 && dlt <= 128 && mk >= 0) ? (1u << e) : 0u; }
            attn_tile_step(m, l, o, qf, kf, vf, vm);
        }
        const float il = 1.0f / fmaxf(l, 1e-30f);
        bf16_t* op = OD + ((size_t)gi * S + tq) * 256 + hi * 64 + 4 * g;
#pragma unroll
        for (int c = 0; c < 4; ++c) { u32x2 w; w.x = pk2(o[c][0] * il, o[c][1] * il); w.y = pk2(o[c][2] * il, o[c][3] * il); *(u32x2*)(op + 16 * c) = w; }
        if (g == 0) LSE[((size_t)gi * S + tq) * 4 + hi] = m + log2f(fmaxf(l, 1e-30f));
    }
}
__device__ __forceinline__ void dil_combine(unsigned char* ws, int tid, int bid, int G) {
    const bf16_t* OD = (const bf16_t*)(ws + WS_OD); const float* LSE = (const float*)(ws + WS_LSE); bf16_t* OB = (bf16_t*)(ws + WS_OB);
    for (int i = bid * NTHR + tid; i < S * 32; i += G * NTHR) {
        const int t = i >> 5, hi = (i >> 3) & 3, ch = i & 7;
        const float l0 = LSE[(size_t)t * 4 + hi], l1 = LSE[((size_t)S + t) * 4 + hi], l2 = LSE[((size_t)2 * S + t) * 4 + hi];
        const float mx = fmaxf(l0, fmaxf(l1, l2));
        float w0 = fexp2(l0 - mx), w1 = fexp2(l1 - mx), w2 = fexp2(l2 - mx); const float iw = 1.0f / (w0 + w1 + w2); w0 *= iw; w1 *= iw; w2 *= iw;
        const size_t off = (size_t)t * 256 + hi * 64 + ch * 8;
        const u32x4 a = *(const u32x4*)(OD + off), b = *(const u32x4*)(OD + (size_t)S * 256 + off), c = *(const u32x4*)(OD + (size_t)2 * S * 256 + off);
        u32x4 w;
        w.x = pk2(w0 * bflo(a.x) + w1 * bflo(b.x) + w2 * bflo(c.x), w0 * bfhi(a.x) + w1 * bfhi(b.x) + w2 * bfhi(c.x));
        w.y = pk2(w0 * bflo(a.y) + w1 * bflo(b.y) + w2 * bflo(c.y), w0 * bfhi(a.y) + w1 * bfhi(b.y) + w2 * bfhi(c.y));
        w.z = pk2(w0 * bflo(a.z) + w1 * bflo(b.z) + w2 * bflo(c.z), w0 * bfhi(a.z) + w1 * bfhi(b.z) + w2 * bfhi(c.z));
        w.w = pk2(w0 * bflo(a.w) + w1 * bflo(b.w) + w2 * bflo(c.w), w0 * bfhi(a.w) + w1 * bfhi(b.w) + w2 * bfhi(c.w));
        *(u32x4*)(OB + off) = w;
    }
}

__device__ __forceinline__ void sgu_phase(ArgsP a, unsigned char* ws, int l, LAS unsigned char* lds, int tid, int bid, int G) {
    constexpr int VRP = 272;
    const int lane = tid & 63, wave = tid >> 6, r = lane & 15, g = lane >> 4;
    const bf16_t* UVG = (const bf16_t*)(ws + WS_UVG); bf16_t* OC = (bf16_t*)(ws + WS_OC); const bf16_t* WSB = (const bf16_t*)(ws + W_SGU);
    const float* lng = a->in[16] + (size_t)l * 512; const float* lnb = a->in[17] + (size_t)l * 512; const float* sb = a->in[19] + (size_t)l * 512;
    LAS unsigned char* vh = lds;
    for (int u = bid; u < 512; u += G) {
        const int n = u >> 2, grp = u & 3, t0 = n * 128;
        __syncthreads();
        for (int tt = 0; tt < 16; ++tt) {
            const int tl = 16 * wave + tt;
            const u32x4 w = *(const u32x4*)(UVG + (size_t)(t0 + tl) * 1024 + 512 + 8 * lane);
            float v[8] = {bflo(w.x), bfhi(w.x), bflo(w.y), bfhi(w.y), bflo(w.z), bfhi(w.z), bflo(w.w), bfhi(w.w)};
            float s = 0.f;
#pragma unroll
            for (int e = 0; e < 8; ++e) s += v[e];
            const float mean = wave_sum(s) * (1.f / 512); float s2 = 0.f;
#pragma unroll
            for (int e = 0; e < 8; ++e) { v[e] -= mean; s2 += v[e] * v[e]; }
            const float rstd = 1.0f / sqrtf(wave_sum(s2) * (1.f / 512) + LN_EPS);
            if ((lane >> 4) == grp) {
                float y[8];
#pragma unroll
                for (int e = 0; e < 8; ++e) y[e] = v[e] * rstd * lng[8 * lane + e] + lnb[8 * lane + e];
                u32x4 o; o.x = pk2(y[0], y[1]); o.y = pk2(y[2], y[3]); o.z = pk2(y[4], y[5]); o.w = pk2(y[6], y[7]);
                *(LAS u32x4*)(vh + tl * VRP + (8 * lane - 128 * grp) * 2) = o;
            }
        }
        __syncthreads();
        f32x4 acc[8];
#pragma unroll
        for (int c = 0; c < 8; ++c) acc[c] = (f32x4){0.f, 0.f, 0.f, 0.f};
        const int nst = (16 * wave + 15) / 32 + 1;
        for (int ks = 0; ks < nst; ++ks) {
            const bf16x8 bfr = *(const bf16x8*)(WSB + ((size_t)grp * 128 + 16 * wave + r) * 128 + 32 * ks + 8 * g);
            LAS const unsigned char* vb = vh + (32 * ks + 8 * g + (r >> 2)) * VRP + (lane & 3) * 8;
#pragma unroll
            for (int c = 0; c < 8; ++c) { const bf16x8 af = cat8(tr_read(vb + c * 32), tr_read(vb + 4 * VRP + c * 32)); acc[c] = mfma16(af, bfr, acc[c]); }
        }
        const int tl = 16 * wave + r; const float bias = sb[grp * 128 + tl];
        const bf16_t* up = UVG + (size_t)(t0 + tl) * 1024 + grp * 128 + 4 * g; bf16_t* op = OC + (size_t)(t0 + tl) * 512 + grp * 128 + 4 * g;
#pragma unroll
        for (int c = 0; c < 8; ++c) { const u32x2 uw = *(const u32x2*)(up + 16 * c);
            u32x2 w; w.x = pk2(bflo(uw.x) * (acc[c][0] + bias), bfhi(uw.x) * (acc[c][1] + bias)); w.y = pk2(bflo(uw.y) * (acc[c][2] + bias), bfhi(uw.y) * (acc[c][3] + bias));
            *(u32x2*)(op + 16 * c) = w; }
    }
}

__device__ __forceinline__ void cmp_mlp_phase(unsigned char* ws, LAS unsigned char* lds, int tid, int bid, int G) {
    const int lane = tid & 63, wave = tid >> 6, r = lane & 15, g = lane >> 4;
    LAS float* red = (LAS float*)lds; LAS unsigned char* hid = lds + 65536;
    for (int u = bid; u < 256; u += G) {
        const int which = u >> 7, grp = (u >> 6) & 1, rt = u & 63;
        const bf16_t* src = (const bf16_t*)(ws + (which ? WS_VC : WS_KC)); const bf16_t* w1t = (const bf16_t*)(ws + (which ? W_P1V : W_P1K)); const bf16_t* w2t = (const bf16_t*)(ws + (which ? W_P2V : W_P2K));
        const float* pb = (const float*)(ws + W_PB) + which * 128; bf16_t* dst = (bf16_t*)(ws + (which ? WS_VCMP : WS_KCMP));
        f32x4 acc[8];
#pragma unroll
        for (int c = 0; c < 8; ++c) acc[c] = (f32x4){0.f, 0.f, 0.f, 0.f};
        for (int ks = 0; ks < 8; ++ks) {
            const int j = 4 * wave + (ks >> 1), d0 = (ks & 1) * 32 + 8 * g, tok = 16 * (16 * rt + r) + j;
            bf16x8 af = {0, 0, 0, 0, 0, 0, 0, 0};
            if (tok < S) af = *(const bf16x8*)(src + (size_t)tok * 128 + grp * 64 + d0);
#pragma unroll
            for (int c = 0; c < 8; ++c) { const bf16x8 bfr = *(const bf16x8*)(w1t + (size_t)(16 * c + r) * 2048 + 256 * wave + 32 * ks + 8 * g); acc[c] = mfma16(af, bfr, acc[c]); }
        }
        __syncthreads();
#pragma unroll
        for (int c = 0; c < 8; ++c)
#pragma unroll
            for (int i = 0; i < 4; ++i) red[wave * 2048 + (4 * g + i) * 128 + 16 * c + r] = acc[c][i];
        __syncthreads();
#pragma unroll
        for (int q = 0; q < 4; ++q) { const int idx = tid * 4 + q, row = idx >> 7, col = idx & 127; float s = pb[col];
#pragma unroll
            for (int w = 0; w < 8; ++w) s += red[w * 2048 + idx];
            *(LAS bf16_t*)(hid + row * 272 + col * 2) = (bf16_t)f2bf(gelu_tanh(s)); }
        __syncthreads();
        if (wave < 4) {
            f32x4 a2 = {0.f, 0.f, 0.f, 0.f};
#pragma unroll
            for (int ks = 0; ks < 4; ++ks) { const bf16x8 af = *(LAS const bf16x8*)(hid + r * 272 + (32 * ks + 8 * g) * 2); const bf16x8 bfr = *(const bf16x8*)(w2t + (size_t)(16 * wave + r) * 128 + 32 * ks + 8 * g); a2 = mfma16(af, bfr, a2); }
#pragma unroll
            for (int i = 0; i < 4; ++i) dst[((size_t)grp * 1024 + 16 * rt + 4 * g + i) * 64 + 16 * wave + r] = (bf16_t)f2bf(a2[i]);
        }
    }
}

__device__ __forceinline__ void cmp_attn_phase(unsigned char* ws, LAS unsigned char* lds, int tid, int bid, int G) {
    const int lane = tid & 63, wave = tid >> 6, r = lane & 15, g = lane >> 4;
    const bf16_t* Q = (const bf16_t*)(ws + WS_QAR); const float* GA = (const float*)(ws + WS_GA); const float* OA32 = (const float*)(ws + WS_OA32); float* OA32B = (float*)(ws + WS_OA32B); unsigned* SEL = (unsigned*)(ws + WS_SEL);
    LAS unsigned char* Kl = lds; LAS unsigned char* Vl = lds + 128 * RP; LAS float* pslc = (LAS float*)(lds + 65536);
    for (int u = bid; u < 1024; u += G) {
        const int tile = u >> 1, grp = u & 1, t0 = tile * 32;
        const bf16_t* Kg = (const bf16_t*)(ws + WS_KCMP) + (size_t)grp * 1024 * 64; const bf16_t* Vg = (const bf16_t*)(ws + WS_VCMP) + (size_t)grp * 1024 * 64;
        const int nk = t0 / 16 + 1;
        const int tokl = 4 * wave + (r >> 2), tok = t0 + tokl, head = r & 3, hh = grp * 4 + head;
        bf16x8 qf[2]; { const bf16_t* qp = Q + (size_t)tok * 512 + hh * 64 + 8 * g; qf[0] = *(const bf16x8*)qp; qf[1] = *(const bf16x8*)(qp + 32); }
        __syncthreads();
        for (int i = tid; i < 32 * 256; i += NTHR) pslc[i] = 0.f;
        float m = -1e30f, l = 0.f;
        const int crow = tid >> 3, cpc = tid & 7;
        u32x4 kr0, kr1, vr0, vr1;
        kr0 = *(const u32x4*)(Kg + (size_t)crow * 64 + cpc * 8); kr1 = *(const u32x4*)(Kg + (size_t)(crow + 64) * 64 + cpc * 8);
        for (int kc = 0; kc < nk; kc += 128) {
            __syncthreads();
            *(LAS u32x4*)(Kl + crow * RP + cpc * 16) = kr0; *(LAS u32x4*)(Kl + (crow + 64) * RP + cpc * 16) = kr1;
            __syncthreads();
            { const int kn = (kc + 128 < nk) ? kc + 128 : 0;
              kr0 = *(const u32x4*)(Kg + (size_t)(kn + crow) * 64 + cpc * 8); kr1 = *(const u32x4*)(Kg + (size_t)(kn + crow + 64) * 64 + cpc * 8); }
            const int nst = ((nk - kc) < 128 ? (nk - kc) : 128);
            for (int st = 0; st * 32 < nst; ++st) {
                const KFrag kf = load_kfrag(Kl + st * 32 * RP, lane);
                float s[8]; scores8(s, kf, qf);
                float mx = -1e30f; unsigned vm = 0;
#pragma unroll
                for (int e = 0; e < 8; ++e) { const int nn = kc + 32 * st + 8 * g + e; const bool ok = 16 * nn + 31 <= tok; vm |= ok ? (1u << e) : 0u; s[e] = ok ? s[e] * QK_SC : -1e30f; mx = fmaxf(mx, s[e]); }
                mx = rmax4(mx);
                const float mn = fmaxf(m, mx); float rs = 0.f;
#pragma unroll
                for (int e = 0; e < 8; ++e) rs += ((vm >> e) & 1u) ? fexp2(s[e] - mn) : 0.f;
                rs = rsum4(rs);
                l = l * fexp2(m - mn) + rs; m = mn;
            }
        }
        const float il = 1.0f / fmaxf(l, 1e-30f);
        f32x4 o[4];
#pragma unroll
        for (int c = 0; c < 4; ++c) o[c] = (f32x4){0.f, 0.f, 0.f, 0.f};
        vr0 = *(const u32x4*)(Vg + (size_t)crow * 64 + cpc * 8); vr1 = *(const u32x4*)(Vg + (size_t)(crow + 64) * 64 + cpc * 8);
        for (int kc = 0; kc < nk; kc += 128) {
            __syncthreads();
            *(LAS u32x4*)(Kl + crow * RP + cpc * 16) = kr0; *(LAS u32x4*)(Kl + (crow + 64) * RP + cpc * 16) = kr1;
            *(LAS u32x4*)(Vl + crow * RP + cpc * 16) = vr0; *(LAS u32x4*)(Vl + (crow + 64) * RP + cpc * 16) = vr1;
            __syncthreads();
            if (kc + 128 < nk) { const int kn = kc + 128;
              kr0 = *(const u32x4*)(Kg + (size_t)(kn + crow) * 64 + cpc * 8); kr1 = *(const u32x4*)(Kg + (size_t)(kn + crow + 64) * 64 + cpc * 8);
              vr0 = *(const u32x4*)(Vg + (size_t)(kn + crow) * 64 + cpc * 8); vr1 = *(const u32x4*)(Vg + (size_t)(kn + crow + 64) * 64 + cpc * 8); }
            const int nst = ((nk - kc) < 128 ? (nk - kc) : 128);
            for (int st = 0; st * 32 < nst; ++st) {
                const KFrag kf = load_kfrag(Kl + st * 32 * RP, lane);
                bf16x8 vf[4]; load_vfrag(vf, Vl + st * 32 * RP, lane);
                float s[8]; scores8(s, kf, qf);
                float p[8];
#pragma unroll
                for (int e = 0; e < 8; ++e) { const int nn = kc + 32 * st + 8 * g + e; const bool ok = 16 * nn + 31 <= tok; p[e] = ok ? fexp2(s[e] * QK_SC - m) * il : 0.f; }
                const bf16x8 pf = pack8(p);
#pragma unroll
                for (int c = 0; c < 4; ++c) o[c] = mfma16(vf[c], pf, o[c]);
                float A = (p[0] + p[1]) + (p[2] + p[3]), B = p[3] + (p[4] + p[5]) + (p[6] + p[7]), C = p[7];
                A += __shfl_xor(A, 1); A += __shfl_xor(A, 2); B += __shfl_xor(B, 1); B += __shfl_xor(B, 2); C += __shfl_xor(C, 1); C += __shfl_xor(C, 2);
                if ((lane & 3) == 0) {
                    const int j0 = (kc + 32 * st) / 4 + 2 * g; float* pp = (float*)(pslc + tokl * 256);
                    atomicAdd(pp + j0, A);
                    if (j0 + 1 < 256) atomicAdd(pp + j0 + 1, B);
                    if (j0 + 2 < 256) atomicAdd(pp + j0 + 2, C);
                }
            }
        }
        { const float sc = GA[(size_t)tok * 24 + hh * 3 + 0];
#pragma unroll
          for (int c = 0; c < 4; ++c) { const size_t off = (size_t)tok * 512 + hh * 64 + 16 * c + 4 * g; *(f32x4*)(OA32B + off) = *(const f32x4*)(OA32 + off) + o[c] * sc; } }
        __syncthreads();
        {
            float v[4][4]; unsigned selb[4];
#pragma unroll
            for (int tk = 0; tk < 4; ++tk) { const int tl = 4 * wave + tk, t = t0 + tl, cur = t >> 6; selb[tk] = 0;
#pragma unroll
                for (int i = 0; i < 4; ++i) { const int j = lane + 64 * i; v[tk][i] = (j > cur) ? -1.f : ((j == 0 || j == cur || j == cur - 1) ? 1e6f : pslc[tl * 256 + j]); } }
            for (int it = 0; it < 16; ++it) {
                float wv[4]; int wj[4];
#pragma unroll
                for (int tk = 0; tk < 4; ++tk) { float bv = v[tk][0]; int bi = 0;
#pragma unroll
                    for (int i = 1; i < 4; ++i) if (v[tk][i] > bv) { bv = v[tk][i]; bi = i; }
                    wv[tk] = bv; wj[tk] = lane + 64 * bi; }
#pragma unroll
                for (int off = 32; off >= 1; off >>= 1) {
#pragma unroll
                    for (int tk = 0; tk < 4; ++tk) { const float ov = __shfl_xor(wv[tk], off); const int oj = __shfl_xor(wj[tk], off); if (ov > wv[tk] || (ov == wv[tk] && oj < wj[tk])) { wv[tk] = ov; wj[tk] = oj; } }
                }
#pragma unroll
                for (int tk = 0; tk < 4; ++tk) if (wv[tk] >= 0.f && (wj[tk] & 63) == lane) { const int idx = wj[tk] >> 6; selb[tk] |= 1u << idx;
#pragma unroll
                    for (int i = 0; i < 4; ++i) if (i == idx) v[tk][i] = -2.f; }
            }
#pragma unroll
            for (int tk = 0; tk < 4; ++tk) { const int t = t0 + 4 * wave + tk;
#pragma unroll
                for (int i = 0; i < 4; ++i) { const unsigned long long bm = __ballot((selb[tk] >> i) & 1u);
                    if (lane == 0) { SEL[((size_t)t * 2 + grp) * 8 + 2 * i] = (unsigned)bm; SEL[((size_t)t * 2 + grp) * 8 + 2 * i + 1] = (unsigned)(bm >> 32); } } }
        }
    }
}

__device__ __forceinline__ void slc_phase(unsigned char* ws, LAS unsigned char* lds, int tid, int bid, int G) {
    const int lane = tid & 63, wave = tid >> 6, r = lane & 15, g = lane >> 4;
    const bf16_t* Q = (const bf16_t*)(ws + WS_QAT); const bf16_t* Kg = (const bf16_t*)(ws + WS_KS); const bf16_t* Vg = (const bf16_t*)(ws + WS_VS);
    const float* GA = (const float*)(ws + WS_GA); const float* OA32 = (const float*)(ws + WS_OA32B); bf16_t* OA = (bf16_t*)(ws + WS_OA); const unsigned* SEL = (const unsigned*)(ws + WS_SEL);
    constexpr int KVB = 128 * RP;
    LAS unsigned* selm = (LAS unsigned*)(lds + 4 * KVB); LAS unsigned* uni = (LAS unsigned*)(lds + 4 * KVB + 2048); LAS unsigned* blist = (LAS unsigned*)(lds + 4 * KVB + 4096);
    for (int u = bid; u < 512; u += G) {
        const int tile = u >> 1, grp = u & 1, t0 = tile * 64, cur = tile;
        __syncthreads();
        selm[tid] = SEL[((size_t)(t0 + (tid >> 3)) * 2 + grp) * 8 + (tid & 7)];
        __syncthreads();
        if (tid < 8) { unsigned x = 0; for (int i = 0; i < 64; ++i) x |= selm[i * 8 + tid]; uni[tid] = x; }
        __syncthreads();
        if (tid < 256) {
            const int wq = tid >> 5; unsigned below = 0, total = 0;
#pragma unroll
            for (int w = 0; w < 8; ++w) { const unsigned x = uni[w]; const unsigned pc = __builtin_popcount(x); total += pc; below += (w < wq) ? pc : 0u; }
            const unsigned mine = uni[wq];
            if ((mine >> (tid & 31)) & 1u) blist[below + __builtin_popcount(mine & ((1u << (tid & 31)) - 1u))] = tid;
            if (tid == 0) blist[256] = total;
        }
        __syncthreads();
        const int nblk = __builtin_amdgcn_readfirstlane((int)blist[256]);
        const int tw = t0 + 8 * wave;
        bf16x8 qf[2][2]; float mr[2], l[2]; f32x4 o[2][4]; unsigned mw[2][8];
#pragma unroll
        for (int qt = 0; qt < 2; ++qt) {
            const int tok = tw + 4 * qt + (r >> 2), head = r & 3;
            const bf16_t* qp = Q + (size_t)tok * 512 + (grp * 4 + head) * 64 + 8 * g; const bf16_t* kp = Kg + (size_t)tok * 128 + grp * 64 + 8 * g;
            qf[qt][0] = *(const bf16x8*)qp; qf[qt][1] = *(const bf16x8*)(qp + 32);
            float d = 0.f;
#pragma unroll
            for (int hf = 0; hf < 2; ++hf) { const u32x4 a = __builtin_bit_cast(u32x4, qf[qt][hf]); const u32x4 b = *(const u32x4*)(kp + 32 * hf);
                d += bflo(a.x) * bflo(b.x) + bfhi(a.x) * bfhi(b.x) + bflo(a.y) * bflo(b.y) + bfhi(a.y) * bfhi(b.y) + bflo(a.z) * bflo(b.z) + bfhi(a.z) * bfhi(b.z) + bflo(a.w) * bflo(b.w) + bfhi(a.w) * bfhi(b.w); }
            mr[qt] = rsum4(d) * QK_SC; l[qt] = 0.f;
#pragma unroll
            for (int c = 0; c < 4; ++c) o[qt][c] = (f32x4){0.f, 0.f, 0.f, 0.f};
#pragma unroll
            for (int w = 0; w < 8; ++w) mw[qt][w] = selm[(8 * wave + 4 * qt + (r >> 2)) * 8 + w];
        }
        const int srow = tid >> 3, spc = tid & 7;
        const int nrounds = (nblk + 3) >> 2;
        u32x4 kreg[4], vreg[4];
#pragma unroll
        for (int b = 0; b < 4; ++b) { kreg[b] = (u32x4){0, 0, 0, 0}; vreg[b] = (u32x4){0, 0, 0, 0};
            if (b < nblk) { const int jj = __builtin_amdgcn_readfirstlane((int)blist[b]); const size_t off = (size_t)(64 * jj + srow) * 128 + grp * 64 + spc * 8; kreg[b] = *(const u32x4*)(Kg + off); vreg[b] = *(const u32x4*)(Vg + off); } }
        for (int rd = 0; rd < nrounds; ++rd) {
            __syncthreads();
#pragma unroll
            for (int b = 0; b < 4; ++b) { LAS unsigned char* kb = lds + b * KVB; *(LAS u32x4*)(kb + srow * RP + spc * 16) = kreg[b]; *(LAS u32x4*)(kb + 64 * RP + srow * RP + spc * 16) = vreg[b]; }
            __syncthreads();
#pragma unroll
            for (int b = 0; b < 4; ++b) { const int jb = (rd + 1) * 4 + b;
                if (jb < nblk) { const int jj = __builtin_amdgcn_readfirstlane((int)blist[jb]); const size_t off = (size_t)(64 * jj + srow) * 128 + grp * 64 + spc * 8; kreg[b] = *(const u32x4*)(Kg + off); vreg[b] = *(const u32x4*)(Vg + off); } }
            for (int b = 0; b < 4; ++b) {
                const int jb = rd * 4 + b; if (jb >= nblk) break;
                const int j = __builtin_amdgcn_readfirstlane((int)blist[jb]);
                LAS unsigned char* Kl = lds + b * KVB; LAS unsigned char* Vl = Kl + 64 * RP;
                bool bit[2]; bool need[2];
#pragma unroll
                for (int qt = 0; qt < 2; ++qt) {
                    unsigned wsel = mw[qt][0];
#pragma unroll
                    for (int w = 1; w < 8; ++w) wsel = ((j >> 5) == w) ? mw[qt][w] : wsel;
                    bit[qt] = (wsel >> (j & 31)) & 1u; need[qt] = __ballot(bit[qt]) != 0ull;
                }
                if (need[0] || need[1]) {
                    const bool diag = (j == cur);
#pragma unroll
                    for (int st = 0; st < 2; ++st) {
                        const KFrag kf = load_kfrag(Kl + st * 32 * RP, lane);
                        bf16x8 vf[4]; load_vfrag(vf, Vl + st * 32 * RP, lane);
#pragma unroll
                        for (int qt = 0; qt < 2; ++qt) {
                            if (!need[qt]) continue;
                            const int t = tw + 4 * qt + (r >> 2);
                            float s[8], p[8]; scores8(s, kf, qf[qt]);
#pragma unroll
                            for (int e = 0; e < 8; ++e) { const int key = 64 * j + 32 * st + 8 * g + e; const bool ok = bit[qt] && (!diag || key <= t); p[e] = ok ? fexp2(s[e] * QK_SC - mr[qt]) : 0.f; l[qt] += p[e]; }
                            const bf16x8 pf = pack8(p);
#pragma unroll
                            for (int c = 0; c < 4; ++c) o[qt][c] = mfma16(vf[c], pf, o[qt][c]);
                        }
                    }
                }
            }
        }
#pragma unroll
        for (int qt = 0; qt < 2; ++qt) {
            const int tok = tw + 4 * qt + (r >> 2), head = r & 3, hh = grp * 4 + head;
            const float sc = GA[(size_t)tok * 24 + hh * 3 + 1] / fmaxf(rsum4(l[qt]), 1e-30f);
#pragma unroll
            for (int c = 0; c < 4; ++c) { const size_t off = (size_t)tok * 512 + hh * 64 + 16 * c + 4 * g; const f32x4 b = *(const f32x4*)(OA32 + off); const f32x4 v = b + o[qt][c] * sc;
                u32x2 w; w.x = pk2(v[0], v[1]); w.y = pk2(v[2], v[3]); *(u32x2*)(OA + off) = w; }
        }
    }
}

__device__ __forceinline__ ArgsP opqa() { ArgsP p = (ArgsP)__builtin_amdgcn_kernarg_segment_ptr(); asm volatile("" : "+s"(p)); return p; }
#ifndef MIX_MASK
#define MIX_MASK 0xff
#endif
__global__ void __launch_bounds__(NTHR, 2) fwd_kernel(Args a) {
    extern __shared__ __attribute__((aligned(16))) unsigned char lds_raw[];
    LAS unsigned char* lds = (LAS unsigned char*)lds_raw;
    cg::grid_group grid = cg::this_grid();
    const int tid0 = threadIdx.x, bid0 = blockIdx.x, G0 = gridDim.x;
    #define WSP ArgsP ap = opqa(); int tid = tid0, bid = bid0, G = G0; asm volatile("" : "+v"(tid), "+s"(bid), "+s"(G)); unsigned char* ws = ap->ws; bf16_t* XB = (bf16_t*)(ws + WS_XB); float* V32 = (float*)(ws + WS_V32); bf16_t* H = (bf16_t*)(ws + WS_H); (void)XB; (void)V32; (void)H;
#pragma unroll 1
    for (int l0 = 0; l0 < DEPTH; ++l0) {
        int l = l0; asm volatile("" : "+s"(l));
        { WSP prologue_phase(ap, l, lds, tid, bid, G); }
        grid.sync();
        { WSP pg8::Gemm g{XB, (const bf16_t*)(ws + W_GU1), S, 5632, 1024}; pg8::StaticOrder so; so.init(S, 5632, G, bid); EpiFfn e{H};
          pg8::gemm_phase<EpiFfn, pg8::StaticOrder, true, true>(lds, g, so, e); }
        grid.sync();
        { WSP pg8::Gemm g{H, (const bf16_t*)(ws + W_D1), S, 1024, FF}; pg8::StaticOrder so; so.init(S, 1024, G, bid); EpiRes e{l == 0 ? ap->in[0] : ap->out, V32, 0.5f};
          pg8::gemm_phase<EpiRes, pg8::StaticOrder, true, true>(lds, g, so, e); }
        grid.sync();
        { WSP ln_phase(V32, ap->in[1] + (size_t)l * 3 * D, ap->in[2] + (size_t)l * 3 * D, ap->out, XB, tid, bid, G); }
        grid.sync();
        { WSP pg8::Gemm g{XB, (const bf16_t*)(ws + W_IN), S, NZ, 1024}; pg8::StaticOrder so; so.init(S, NZ, G, bid); EpiZ e{ws};
          pg8::gemm_phase<EpiZ, pg8::StaticOrder, true, true>(lds, g, so, e); }
        grid.sync();
        { WSP cmp_mlp_phase(ws, lds, tid, bid, G); }
        { WSP sgu_phase(ap, ws, l, lds, tid, bid, G); }
        { WSP dil_phase(ws, lds, tid, bid, G); }
        { WSP win_phase(ws, lds, tid, bid, G); }
        grid.sync();
        { WSP dil_combine(ws, tid, bid, G); }
        { WSP cmp_attn_phase(ws, lds, tid, bid, G); }
        grid.sync();
        { WSP slc_phase(ws, lds, tid, bid, G); }
        grid.sync();
        { WSP pg8::Gemm g{(const bf16_t*)(ws + WS_OA), (const bf16_t*)(ws + W_A), S, 1024, 512}; pg8::StaticOrder so; so.init(S, 1024, G, bid); EpiGate e{(const bf16_t*)(ws + WS_GM), (float*)(ws + WS_M32), (bf16_t*)(ws + WS_MB), 0, 0};
          pg8::gemm_phase<EpiGate, pg8::StaticOrder, true, true>(lds, g, so, e); }
        { WSP pg8::Gemm g{(const bf16_t*)(ws + WS_OB), (const bf16_t*)(ws + W_B), S, 1024, 256}; pg8::StaticOrder so; so.init(S, 1024, G, bid); EpiGate e{(const bf16_t*)(ws + WS_GM), (float*)(ws + WS_M32), (bf16_t*)(ws + WS_MB), 1024, 1};
          pg8::gemm_phase<EpiGate, pg8::StaticOrder, true, true>(lds, g, so, e); }
        { WSP pg8::Gemm g{(const bf16_t*)(ws + WS_OC), (const bf16_t*)(ws + W_C), S, 1024, 512}; pg8::StaticOrder so; so.init(S, 1024, G, bid); EpiGate e{(const bf16_t*)(ws + WS_GM), (float*)(ws + WS_M32), (bf16_t*)(ws + WS_MB), 2048, 2};
          pg8::gemm_phase<EpiGate, pg8::StaticOrder, true, true>(lds, g, so, e); }
        grid.sync();
        { WSP pg8::Gemm g{(const bf16_t*)(ws + WS_MB), (const bf16_t*)(ws + W_O), S, 1024, 1024}; pg8::StaticOrder so; so.init(S, 1024, G, bid); EpiRes e{ap->out, V32, 1.0f};
          pg8::gemm_phase<EpiRes, pg8::StaticOrder, true, true>(lds, g, so, e); }
        grid.sync();
        { WSP ln_phase(V32, ap->in[1] + (size_t)l * 3 * D + D, ap->in[2] + (size_t)l * 3 * D + D, ap->out, XB, tid, bid, G); }
        grid.sync();
        { WSP pg8::Gemm g{XB, (const bf16_t*)(ws + W_GU2), S, 5632, 1024}; pg8::StaticOrder so; so.init(S, 5632, G, bid); EpiFfn e{H};
          pg8::gemm_phase<EpiFfn, pg8::StaticOrder, true, true>(lds, g, so, e); }
        grid.sync();
        { WSP pg8::Gemm g{H, (const bf16_t*)(ws + W_D2), S, 1024, FF}; pg8::StaticOrder so; so.init(S, 1024, G, bid); EpiRes e{ap->out, V32, 0.5f};
          pg8::gemm_phase<EpiRes, pg8::StaticOrder, true, true>(lds, g, so, e); }
        grid.sync();
        { WSP ln_phase(V32, ap->in[1] + (size_t)l * 3 * D + 2 * D, ap->in[2] + (size_t)l * 3 * D + 2 * D, ap->out, XB, tid, bid, G); }
        grid.sync();
    }
    #undef WSP
}

extern "C" void kernel_launch(void* const* d_in, const int* in_sizes, int n_in, void* d_out, int out_size, void* d_ws, size_t ws_size, hipStream_t stream) {
    static int grid = 0;
    if (grid == 0) {
        if (n_in != 24 || in_sizes[0] != S * D || out_size != S * D || ws_size < WS_END) { fprintf(stderr, "kernel_launch: unexpected shapes (n_in %d, in0 %d, out %d, ws %zu)\n", n_in, n_in > 0 ? in_sizes[0] : -1, out_size, ws_size); grid = -1; return; }
        int dev = 0, cus = 0, per_cu = 0;
        hipGetDevice(&dev); hipDeviceGetAttribute(&cus, hipDeviceAttributeMultiprocessorCount, dev);
        if (hipFuncSetAttribute((const void*)fwd_kernel, hipFuncAttributeMaxDynamicSharedMemorySize, LDS_BYTES) != hipSuccess) { fprintf(stderr, "kernel_launch: hipFuncSetAttribute failed\n"); grid = -1; return; }
        if (hipOccupancyMaxActiveBlocksPerMultiprocessor(&per_cu, (const void*)fwd_kernel, NTHR, LDS_BYTES) != hipSuccess || per_cu < 1) { fprintf(stderr, "kernel_launch: occupancy query gave %d\n", per_cu); per_cu = 1; }
        (void)hipGetLastError();
        grid = cus;
    }
    if (grid < 0) return;
    Args a{};
    for (int i = 0; i < 24; ++i) a.in[i] = (const float*)d_in[i];
    a.out = (float*)d_out; a.ws = (unsigned char*)d_ws;
    for (int d = 0; d < 32; ++d) { const float p = (float)pow(10000.0, (double)d / 32.0); a.inv[d] = 1.0f / p; }
    void* args[] = {&a};
    hipError_t e = hipLaunchCooperativeKernel((const void*)fwd_kernel, dim3(grid), dim3(NTHR), args, LDS_BYTES, stream);
    if (e != hipSuccess) fprintf(stderr, "cooperative launch failed: %s (grid %d)\n", hipGetErrorString(e), grid);
}
```

```cpp
#include <hip/hip_runtime.h>
#include <hip/hip_cooperative_groups.h>
#include <cstdio>
#include <cstdint>
#include <cmath>
namespace cg = cooperative_groups;
namespace pg8 {
#define PG8_LAS __attribute__((address_space(3)))
typedef unsigned short bf16_t;
typedef short bf16x8 __attribute__((ext_vector_type(8)));
typedef float f32x4 __attribute__((ext_vector_type(4)));
typedef unsigned u32x4 __attribute__((ext_vector_type(4)));
constexpr int BM = 256, BK = 64, HALF = 128, HTB = HALF * BK * 2  , STAGE_BYTES = 8 * HTB, NXCD = 8, WGM = 8;

__host__ __device__ __forceinline__ int lds_byte(int r, int c) { const int st = (r >> 4) * 2 + (c >> 5), rr = r & 15, cc = c & 31, ob = rr * 64 + cc * 2; return st * 1024 + (ob ^ (((ob >> 9) & 1) << 5)); }
__host__ __device__ __forceinline__ void stage_rc(int b, int& R, int& C) { const int st = b / 1024, sb = b % 1024, swz = sb ^ (((sb >> 9) & 1) << 5); R = (st >> 1) * 16 + swz / 64; C = (st & 1) * 32 + (swz % 64) / 2; }
__host__ __device__ __forceinline__ int perm32(int rho) { const int n = rho >> 4, i = rho & 15; return 8 * (i >> 2) + 4 * n + (i & 3); }

struct Unit { int pm, pn; };
struct Gemm { const bf16_t* A; const bf16_t* Bt; int M, N, K; };

struct StaticOrder {
    int nM, nN, nwg, G, c;
    __host__ __device__ void init(int M, int N, int G_, int c_) { nM = M / BM; nN = N / BM; nwg = nM * nN; G = G_; c = c_; }
    __host__ __device__ bool next(int i, Unit& u) const {
        const long L = (long)i * G + c; if (L >= nwg) return false;
        int wgid = (int)L; { const int q = nwg / NXCD, r = nwg % NXCD, xcd = wgid % NXCD, off = wgid / NXCD; wgid = (xcd < r ? xcd * (q + 1) : r * (q + 1) + (xcd - r) * q) + off; }
        const int nig = WGM * nN, gid = wgid / nig, fm = gid * WGM, gsz = (nM - fm) < WGM ? (nM - fm) : WGM;
        u.pm = fm + ((wgid % nig) % gsz); u.pn = (wgid % nig) / gsz; return true;
    }
    __device__ __forceinline__ void a_ready(const Unit&) const {}
    __device__ __forceinline__ void done(const Unit&) const {}
};

__device__ __forceinline__ unsigned cvt_pk_bf16(float lo, float hi) { unsigned r; asm volatile("v_cvt_pk_bf16_f32 %0, %1, %2" : "=v"(r) : "v"(lo), "v"(hi)); return r; }
typedef float f32x2 __attribute__((ext_vector_type(2)));
__device__ __forceinline__ f32x2 gelu_pk(f32x2 v) {
    const f32x2 av = __builtin_elementwise_abs(v), d = av * 0.2316418882f + 1.0f;
    f32x2 t; t.x = __builtin_amdgcn_rcpf(d.x); t.y = __builtin_amdgcn_rcpf(d.y);
    f32x2 q = t * 0.5307027145f + (-0.7265760135f); q = q * t + 0.7107068705f; q = q * t + (-0.142248368f); q = q * t + 0.127414796f; q = q * t;
    const f32x2 s = (v * v) * (-0.72134752044f);
    f32x2 e; e.x = __builtin_amdgcn_exp2f(s.x); e.y = __builtin_amdgcn_exp2f(s.y);
    const f32x2 m = v * (q * e), r = v - m;
    f32x2 o; o.x = v.x < 0.f ? m.x : r.x; o.y = v.y < 0.f ? m.y : r.y; return o;
}

template <int ACT  > struct EpiBf16 {
    static constexpr bool PERM = true, AFTER_DRAIN = false; static_assert(ACT == 0 || ACT == 1, "EpiBf16: ACT is 0 (none) or 1 (gelu_pk)");
    bf16_t* O; int ldc; const float* bias; int split_cols; size_t split_stride; float scale0;
    __device__ __forceinline__ void operator()(const f32x4 (&acc)[2][2][4][2], const Unit& u, int wr, int wc, int fr, int fq) const {
        const int row0 = u.pm * BM + wr * 64 + fr; int colt = u.pn * BM; bf16_t* base = O;
        float sc = 1.f; if (split_cols) { const int t = colt / split_cols; base += (size_t)t * split_stride; colt -= t * split_cols; if (t == 0) sc = scale0; }
        const int col0 = colt + wc * 32 + 8 * fq, bcol0 = u.pn * BM + wc * 32 + 8 * fq;
        f32x4 bv[2][2];
#pragma unroll
        for (int bj = 0; bj < 2; ++bj)
#pragma unroll
            for (int n = 0; n < 2; ++n) bv[bj][n] = bias ? *(const f32x4*)(bias + bcol0 + bj * HALF + 4 * n) : (f32x4){0.f, 0.f, 0.f, 0.f};
#pragma unroll
        for (int ai = 0; ai < 2; ++ai)
#pragma unroll
            for (int m = 0; m < 4; ++m) { bf16_t* rowp = base + (size_t)(row0 + ai * HALF + m * 16) * ldc + col0;
#pragma unroll
                for (int bj = 0; bj < 2; ++bj) { f32x4 v0 = acc[ai][bj][m][0] + bv[bj][0], v1 = acc[ai][bj][m][1] + bv[bj][1];
                    if (ACT == 1) { f32x2 a = gelu_pk((f32x2){v0[0], v0[1]}), b = gelu_pk((f32x2){v0[2], v0[3]}), c = gelu_pk((f32x2){v1[0], v1[1]}), d = gelu_pk((f32x2){v1[2], v1[3]});
                        v0 = (f32x4){a.x, a.y, b.x, b.y}; v1 = (f32x4){c.x, c.y, d.x, d.y}; }
                    v0 = v0 * sc; v1 = v1 * sc; u32x4 w; w.x = cvt_pk_bf16(v0[0], v0[1]); w.y = cvt_pk_bf16(v0[2], v0[3]); w.z = cvt_pk_bf16(v1[0], v1[1]); w.w = cvt_pk_bf16(v1[2], v1[3]);
                    *(u32x4*)(rowp + bj * HALF) = w; } }
    }
};


template <class Epi, class Sched, bool ALIGN_EPI = false, bool SP2 = false>
__device__ __forceinline__ void gemm_phase(PG8_LAS unsigned char* lds, const Gemm g, const Sched& S, const Epi& E) {
    int tid_ = threadIdx.x; asm volatile("" : "+v"(tid_)); const int tid = tid_, wid = __builtin_amdgcn_readfirstlane(tid >> 6), lane = tid & 63, wr = wid >> 2, wc = wid & 3, fr = lane & 15, fq = lane >> 4;
    const int K = g.K, nt = K / BK;
    unsigned voffA[2], voffB[2];
#pragma unroll
    for (int i = 0; i < 2; ++i) { int R, C; stage_rc(tid * 16 + i * 8192, R, C); const int Rb = Epi::PERM ? ((R & ~31) + perm32(R & 31)) : R;
        voffA[i] = (unsigned)(R * K + C) * 2u; voffB[i] = (unsigned)(Rb * K + C) * 2u; }
    const size_t kstep = (size_t)(BK * 2);
    const size_t hstep = (size_t)HALF * K * 2;
    const size_t tstep = 2 * hstep;
    const unsigned ldsw = (unsigned)wid * 1024u;
    const int aoff = lds_byte(wr * 64 + fr, fq * 8), boff = lds_byte(wc * 32 + fr, fq * 8);
#define PG8_SA(b, h) (((b) * 2 + (h)) * HTB)
#define PG8_SB(b, h) ((4 + (b) * 2 + (h)) * HTB)
#define PG8_STAGE(bufoff, gbase, voff) do { _Pragma("unroll") for (int _i = 0; _i < 2; ++_i) \
        __builtin_amdgcn_global_load_lds((const unsigned*)((const char*)(gbase) + (voff)[_i]), (PG8_LAS unsigned*)(lds + (bufoff) + ldsw + _i * 8192), 16, 0, 0); } while (0)
#define PG8_LDA(dst, b, h) do { _Pragma("unroll") for (int m = 0; m < 4; ++m) _Pragma("unroll") for (int k = 0; k < 2; ++k) dst[m][k] = *(const PG8_LAS bf16x8*)(lds + PG8_SA(b, h) + aoff + m * 2048 + k * 1024); } while (0)
#define PG8_LDB(dst, b, h) do { _Pragma("unroll") for (int n = 0; n < 2; ++n) _Pragma("unroll") for (int k = 0; k < 2; ++k) dst[n][k] = *(const PG8_LAS bf16x8*)(lds + PG8_SB(b, h) + boff + n * 2048 + k * 1024); } while (0)
#define PG8_MMA(ai, bj, At, Bt) do { __builtin_amdgcn_s_setprio(1); _Pragma("unroll") for (int m = 0; m < 4; ++m) _Pragma("unroll") for (int n = 0; n < 2; ++n) _Pragma("unroll") for (int k = 0; k < 2; ++k) \
        acc[ai][bj][m][n] = __builtin_amdgcn_mfma_f32_16x16x32_bf16(Bt[n][k], At[m][k], acc[ai][bj][m][n], 0, 0, 0); __builtin_amdgcn_s_setprio(0); } while (0)
#define PG8_WAIT_V(n) asm volatile("s_waitcnt vmcnt(" #n ")" ::: "memory")
#define PG8_WAIT_L(n) asm volatile("s_waitcnt lgkmcnt(" #n ")" ::: "memory")
#define PG8_BAR __builtin_amdgcn_s_barrier()
#define PG8_SCHED __builtin_amdgcn_sched_barrier(0)
    Unit cur, nxt; int ui = 0;
    if (!S.next(0, cur)) return;
    f32x4 acc[2][2][4][2];
#pragma unroll
    for (int a = 0; a < 2; ++a)
#pragma unroll
        for (int b = 0; b < 2; ++b)
#pragma unroll
            for (int m = 0; m < 4; ++m)
#pragma unroll
                for (int n = 0; n < 2; ++n) acc[a][b][m][n] = (f32x4){0.f, 0.f, 0.f, 0.f};
    bf16x8 At[4][2], B0[2][2], B1[2][2];
    const char* cA = (const char*)g.A + (size_t)cur.pm * tstep; const char* cB = (const char*)g.Bt + (size_t)cur.pn * tstep;
    S.a_ready(cur);
    if constexpr (SP2) {
        PG8_STAGE(PG8_SB(0, 0), cB, voffB); PG8_STAGE(PG8_SB(0, 1), cB + hstep, voffB); PG8_STAGE(PG8_SA(0, 0), cA, voffA); PG8_STAGE(PG8_SA(0, 1), cA + hstep, voffA);
        if (wr == 1) PG8_BAR;
        PG8_WAIT_V(2); PG8_BAR;
        PG8_STAGE(PG8_SB(1, 0), cB + kstep, voffB); PG8_STAGE(PG8_SA(1, 0), cA + kstep, voffA); PG8_STAGE(PG8_SB(1, 1), cB + hstep + kstep, voffB);
        PG8_WAIT_V(6); PG8_BAR;
    } else {
        PG8_STAGE(PG8_SB(0, 0), cB, voffB); PG8_STAGE(PG8_SA(0, 0), cA, voffA); PG8_STAGE(PG8_SB(0, 1), cB + hstep, voffB); PG8_STAGE(PG8_SA(0, 1), cA + hstep, voffA);
        if (wr == 1) PG8_BAR;
        PG8_WAIT_V(4); PG8_BAR;
        PG8_STAGE(PG8_SB(1, 0), cB + kstep, voffB); PG8_STAGE(PG8_SA(1, 0), cA + kstep, voffA); PG8_STAGE(PG8_SB(1, 1), cB + hstep + kstep, voffB);
        PG8_WAIT_V(6); PG8_BAR;
    }
    for (;;) {
        const bool has_next = S.next(ui + 1, nxt);
        const char* nA = has_next ? (const char*)g.A + (size_t)nxt.pm * tstep : cA; const char* nB = has_next ? (const char*)g.Bt + (size_t)nxt.pn * tstep : cB;
        for (int t = 0; t < nt; t += 2) {
            const bool last = (t == nt - 2);
            const char* a1 = cA + (size_t)(t + 1) * kstep;
            const char* a2 = last ? nA : cA + (size_t)(t + 2) * kstep; const char* b2 = last ? nB : cB + (size_t)(t + 2) * kstep;
            const char* a3 = a2 + kstep; const char* b3 = b2 + kstep;
            if (last && has_next) S.a_ready(nxt);
            if constexpr (SP2) {
            PG8_LDB(B0, 0, 0); PG8_LDB(B1, 0, 1); PG8_SCHED; PG8_LDA(At, 0, 0); PG8_STAGE(PG8_SA(1, 1), a1 + hstep, voffA);
            PG8_WAIT_V(8); PG8_WAIT_L(0); PG8_BAR; PG8_MMA(0, 0, At, B0); PG8_MMA(0, 1, At, B1); PG8_BAR; PG8_SCHED;
            PG8_LDA(At, 0, 1); PG8_STAGE(PG8_SB(0, 0), b2, voffB); PG8_STAGE(PG8_SB(0, 1), b2 + hstep, voffB); PG8_STAGE(PG8_SA(0, 0), a2, voffA);
            PG8_WAIT_V(8); PG8_WAIT_L(0); PG8_BAR; PG8_MMA(1, 0, At, B0); PG8_MMA(1, 1, At, B1); PG8_BAR; PG8_SCHED;
            PG8_LDB(B0, 1, 0); PG8_LDB(B1, 1, 1); PG8_SCHED; PG8_LDA(At, 1, 0); PG8_STAGE(PG8_SA(0, 1), a2 + hstep, voffA);
            PG8_WAIT_V(8); PG8_WAIT_L(0); PG8_BAR; PG8_MMA(0, 0, At, B0); PG8_MMA(0, 1, At, B1); PG8_BAR; PG8_SCHED;
            PG8_LDA(At, 1, 1); PG8_STAGE(PG8_SB(1, 0), b3, voffB); PG8_STAGE(PG8_SB(1, 1), b3 + hstep, voffB); PG8_STAGE(PG8_SA(1, 0), a3, voffA);
            PG8_WAIT_V(8); PG8_WAIT_L(0); PG8_BAR; PG8_MMA(1, 0, At, B0); PG8_MMA(1, 1, At, B1); PG8_BAR; PG8_SCHED;
            } else {
            PG8_LDB(B0, 0, 0); PG8_SCHED; PG8_LDA(At, 0, 0); PG8_STAGE(PG8_SA(1, 1), a1 + hstep, voffA);
            PG8_WAIT_L(8); PG8_BAR; PG8_WAIT_L(0); PG8_MMA(0, 0, At, B0); PG8_BAR; PG8_SCHED;
            PG8_LDB(B1, 0, 1); PG8_STAGE(PG8_SB(0, 0), b2, voffB);
            PG8_BAR; PG8_WAIT_L(0); PG8_MMA(0, 1, At, B1); PG8_BAR;
            PG8_LDA(At, 0, 1); PG8_STAGE(PG8_SA(0, 0), a2, voffA);
            PG8_BAR; PG8_WAIT_L(0); PG8_MMA(1, 0, At, B0); PG8_BAR; PG8_SCHED;
            PG8_STAGE(PG8_SB(0, 1), b2 + hstep, voffB);
            PG8_WAIT_V(6); PG8_BAR; PG8_MMA(1, 1, At, B1); PG8_BAR;
            PG8_LDB(B0, 1, 0); PG8_SCHED; PG8_LDA(At, 1, 0); PG8_STAGE(PG8_SA(0, 1), a2 + hstep, voffA);
            PG8_WAIT_L(8); PG8_BAR; PG8_WAIT_L(0); PG8_MMA(0, 0, At, B0); PG8_BAR; PG8_SCHED;
            PG8_LDB(B1, 1, 1); PG8_STAGE(PG8_SB(1, 0), b3, voffB);
            PG8_BAR; PG8_WAIT_L(0); PG8_MMA(0, 1, At, B1); PG8_BAR;
            PG8_LDA(At, 1, 1); PG8_STAGE(PG8_SA(1, 0), a3, voffA);
            PG8_BAR; PG8_WAIT_L(0); PG8_MMA(1, 0, At, B0); PG8_BAR; PG8_SCHED;
            PG8_STAGE(PG8_SB(1, 1), b3 + hstep, voffB);
            PG8_WAIT_V(6); PG8_BAR; PG8_MMA(1, 1, At, B1); PG8_BAR;
            }
        }
        if constexpr (ALIGN_EPI) { if (wr == 0) PG8_BAR; }
        if constexpr (!Epi::AFTER_DRAIN) { E(acc, cur, wr, wc, fr, fq); S.done(cur); }
        if (!has_next) break;
#pragma unroll
        for (int a = 0; a < 2; ++a)
#pragma unroll
            for (int b = 0; b < 2; ++b)
#pragma unroll
                for (int m = 0; m < 4; ++m)
#pragma unroll
                    for (int n = 0; n < 2; ++n) acc[a][b][m][n] = (f32x4){0.f, 0.f, 0.f, 0.f};
        cur = nxt; cA = nA; cB = nB; ++ui;
        if constexpr (ALIGN_EPI) { if (wr == 1) PG8_BAR; }
    }
    PG8_WAIT_V(0);
    if constexpr (!ALIGN_EPI) { if (wr == 0) PG8_BAR; }
    PG8_BAR;
    if constexpr (Epi::AFTER_DRAIN) { E.fused(acc, cur, wr, wc, fr, fq, lds, wid, lane); S.done(cur); }
#undef PG8_SA
#undef PG8_SB
#undef PG8_STAGE
#undef PG8_LDA
#undef PG8_LDB
#undef PG8_MMA
#undef PG8_WAIT_V
#undef PG8_WAIT_L
#undef PG8_BAR
#undef PG8_SCHED
}
}

#define LAS __attribute__((address_space(3)))
typedef unsigned short bf16_t;
typedef short bf16x8 __attribute__((ext_vector_type(8)));
typedef short s16x4 __attribute__((ext_vector_type(4)));
typedef short v4i16_t __attribute__((ext_vector_type(4)));
typedef float f32x4 __attribute__((ext_vector_type(4)));
typedef unsigned u32x4 __attribute__((ext_vector_type(4)));
typedef unsigned u32x2 __attribute__((ext_vector_type(2)));

constexpr int S = 16384, D = 1024, FF = 2816, DEPTH = 4, NZ = 7936, INC = 7704;
constexpr float ALPHA = 1.6817928305074292f;
constexpr float LN_EPS = 1e-5f;
constexpr float LOG2E = 1.4426950408889634f;
constexpr float QK_SC = 0.125f * LOG2E;
constexpr int NTHR = 512;
constexpr int LDS_BYTES = 155648;

constexpr size_t MiB = 1u << 20;
constexpr size_t W_GU1 = 1 * MiB;
constexpr size_t W_D1 = W_GU1 + (size_t)5632 * 1024 * 2;
constexpr size_t W_GU2 = W_D1 + (size_t)1024 * 2816 * 2;
constexpr size_t W_D2 = W_GU2 + (size_t)5632 * 1024 * 2;
constexpr size_t W_IN = W_D2 + (size_t)1024 * 2816 * 2;
constexpr size_t W_A = W_IN + (size_t)NZ * 1024 * 2;
constexpr size_t W_B = W_A + (size_t)1024 * 512 * 2;
constexpr size_t W_C = W_B + (size_t)1024 * 256 * 2;
constexpr size_t W_O = W_C + (size_t)1024 * 512 * 2;
constexpr size_t W_P1K = W_O + (size_t)1024 * 1024 * 2;
constexpr size_t W_P1V = W_P1K + (size_t)128 * 2048 * 2;
constexpr size_t W_P2K = W_P1V + (size_t)128 * 2048 * 2;
constexpr size_t W_P2V = W_P2K + (size_t)64 * 128 * 2;
constexpr size_t W_SGU = W_P2V + (size_t)64 * 128 * 2;
constexpr size_t W_PB = W_SGU + (size_t)4 * 128 * 128 * 2;
constexpr size_t W_END = W_PB + 2 * 128 * 4;
static_assert(W_END <= 57 * MiB, "weights region");
constexpr size_t WS_COS = 57 * MiB, WS_SIN = 59 * MiB;
constexpr size_t WS_XB = 61 * MiB;
constexpr size_t WS_V32 = 93 * MiB, WS_OA32 = WS_V32, WS_OA32B = WS_V32 + 32 * MiB;
constexpr size_t WS_H = 157 * MiB;
constexpr size_t WS_QAR = 157 * MiB, WS_QAT = 173 * MiB, WS_KS = 189 * MiB, WS_KW = 193 * MiB, WS_KC = 197 * MiB, WS_VC = 201 * MiB, WS_VS = 205 * MiB, WS_VW = 209 * MiB;
constexpr size_t WS_QB = 213 * MiB, WS_KB = 237 * MiB, WS_VB = 261 * MiB, WS_UVG = 285 * MiB, WS_GM = 317 * MiB, WS_GA = 413 * MiB;
constexpr size_t WS_M32 = 213 * MiB, WS_MB = 285 * MiB;
constexpr size_t WS_OA = 415 * MiB, WS_OB = 431 * MiB, WS_OC = 439 * MiB, WS_OD = 455 * MiB, WS_LSE = 479 * MiB, WS_SEL = 480 * MiB, WS_KCMP = 481 * MiB, WS_VCMP = 481 * MiB + 512 * 1024;
constexpr size_t WS_END = 482 * MiB;

struct Args { const float* in[24]; float* out; unsigned char* ws; float inv[32]; };
typedef const __attribute__((address_space(4))) Args* ArgsP;

__device__ __forceinline__ unsigned f2bf(float f) { unsigned u = __builtin_bit_cast(unsigned, f); return (u + 0x7fffu + ((u >> 16) & 1u)) >> 16; }
__device__ __forceinline__ unsigned pk2(float lo, float hi) { return pg8::cvt_pk_bf16(lo, hi); }
__device__ __forceinline__ float bf2f(unsigned short b) { return __builtin_bit_cast(float, (unsigned)b << 16); }
__device__ __forceinline__ float bflo(unsigned w) { return __builtin_bit_cast(float, w << 16); }
__device__ __forceinline__ float bfhi(unsigned w) { return __builtin_bit_cast(float, w & 0xffff0000u); }
__device__ __forceinline__ float fexp2(float x) { return __builtin_amdgcn_exp2f(x); }
__device__ __forceinline__ float frcp(float x) { return __builtin_amdgcn_rcpf(x); }
__device__ __forceinline__ float sigmoidf_(float x) { return frcp(1.0f + fexp2(-x * LOG2E)); }
__device__ __forceinline__ float siluf_(float x) { return x * sigmoidf_(x); }
__device__ __forceinline__ float gelu_tanh(float x) { const float u = 0.7978845608028654f * (x + 0.044715f * x * x * x); return x * frcp(1.0f + fexp2(-2.0f * LOG2E * u)); }
__device__ __forceinline__ float wave_sum(float v) {
#pragma unroll
    for (int o = 1; o < 64; o <<= 1) v += __shfl_xor(v, o);
    return v;
}
__device__ __forceinline__ f32x4 mfma16(bf16x8 a, bf16x8 b, f32x4 c) { return __builtin_amdgcn_mfma_f32_16x16x32_bf16(a, b, c, 0, 0, 0); }
__device__ __forceinline__ s16x4 tr_read(LAS const unsigned char* p) { return __builtin_bit_cast(s16x4, __builtin_amdgcn_ds_read_tr16_b64_v4i16((LAS v4i16_t*)p)); }
__device__ __forceinline__ bf16x8 cat8(s16x4 lo, s16x4 hi) { return (bf16x8){lo[0], lo[1], lo[2], lo[3], hi[0], hi[1], hi[2], hi[3]}; }
__device__ __forceinline__ bf16x8 pack8(const float (&p)[8]) {
    u32x4 w; w.x = pk2(p[0], p[1]); w.y = pk2(p[2], p[3]); w.z = pk2(p[4], p[5]); w.w = pk2(p[6], p[7]);
    return __builtin_bit_cast(bf16x8, w);
}

struct EpiFfn {
    static constexpr bool PERM = true, AFTER_DRAIN = false;
    bf16_t* H;
    __device__ __forceinline__ void operator()(const f32x4 (&acc)[2][2][4][2], const pg8::Unit& u, int wr, int wc, int fr, int fq) const {
        const int row0 = u.pm * 256 + wr * 64 + fr, col0 = u.pn * 128 + wc * 32 + 8 * fq;
#pragma unroll
        for (int ai = 0; ai < 2; ++ai)
#pragma unroll
            for (int m = 0; m < 4; ++m) {
                bf16_t* rowp = H + (size_t)(row0 + ai * 128 + m * 16) * FF + col0;
                float h[8];
#pragma unroll
                for (int n = 0; n < 2; ++n)
#pragma unroll
                    for (int i = 0; i < 4; ++i) h[4 * n + i] = siluf_(acc[ai][0][m][n][i]) * acc[ai][1][m][n][i];
                u32x4 w; w.x = pk2(h[0], h[1]); w.y = pk2(h[2], h[3]); w.z = pk2(h[4], h[5]); w.w = pk2(h[6], h[7]);
                *(u32x4*)rowp = w;
            }
    }
};
struct EpiRes {
    static constexpr bool PERM = false, AFTER_DRAIN = false;
    const float* X; float* V; float sc;
    __device__ __forceinline__ void operator()(const f32x4 (&acc)[2][2][4][2], const pg8::Unit& u, int wr, int wc, int fr, int fq) const {
        const int row0 = u.pm * 256 + wr * 64 + fr, col0 = u.pn * 256 + wc * 32 + 4 * fq;
#pragma unroll
        for (int ai = 0; ai < 2; ++ai)
#pragma unroll
            for (int m = 0; m < 4; ++m) {
                const size_t off = (size_t)(row0 + ai * 128 + m * 16) * D + col0;
#pragma unroll
                for (int bj = 0; bj < 2; ++bj)
#pragma unroll
                    for (int n = 0; n < 2; ++n) {
                        const f32x4 x = *(const f32x4*)(X + off + bj * 128 + n * 16);
                        *(f32x4*)(V + off + bj * 128 + n * 16) = x * ALPHA + acc[ai][bj][m][n] * sc;
                    }
            }
    }
};
struct EpiGate {
    static constexpr bool PERM = true, AFTER_DRAIN = false;
    const bf16_t* GM; float* M32; bf16_t* MB; int goff, mode;
    __device__ __forceinline__ void operator()(const f32x4 (&acc)[2][2][4][2], const pg8::Unit& u, int wr, int wc, int fr, int fq) const {
        const int row0 = u.pm * 256 + wr * 64 + fr, col0 = u.pn * 256 + wc * 32 + 8 * fq;
#pragma unroll
        for (int ai = 0; ai < 2; ++ai)
#pragma unroll
            for (int m = 0; m < 4; ++m) {
                const int row = row0 + ai * 128 + m * 16;
#pragma unroll
                for (int bj = 0; bj < 2; ++bj) {
                    const int col = col0 + bj * 128;
                    const u32x4 gw = *(const u32x4*)(GM + (size_t)row * 3072 + goff + col);
                    float v[8];
                    v[0] = bflo(gw.x) * acc[ai][bj][m][0][0]; v[1] = bfhi(gw.x) * acc[ai][bj][m][0][1]; v[2] = bflo(gw.y) * acc[ai][bj][m][0][2]; v[3] = bfhi(gw.y) * acc[ai][bj][m][0][3];
                    v[4] = bflo(gw.z) * acc[ai][bj][m][1][0]; v[5] = bfhi(gw.z) * acc[ai][bj][m][1][1]; v[6] = bflo(gw.w) * acc[ai][bj][m][1][2]; v[7] = bfhi(gw.w) * acc[ai][bj][m][1][3];
                    float* mp = M32 + (size_t)row * D + col;
                    if (mode != 0) { const f32x4 a = *(const f32x4*)mp, b = *(const f32x4*)(mp + 4); v[0] += a[0]; v[1] += a[1]; v[2] += a[2]; v[3] += a[3]; v[4] += b[0]; v[5] += b[1]; v[6] += b[2]; v[7] += b[3]; }
                    if (mode != 2) { *(f32x4*)mp = (f32x4){v[0], v[1], v[2], v[3]}; *(f32x4*)(mp + 4) = (f32x4){v[4], v[5], v[6], v[7]}; }
                    else { u32x4 w; w.x = pk2(v[0], v[1]); w.y = pk2(v[2], v[3]); w.z = pk2(v[4], v[5]); w.w = pk2(v[6], v[7]); *(u32x4*)(MB + (size_t)row * D + col) = w; }
                }
            }
    }
};
struct EpiZ {
    static constexpr bool PERM = true, AFTER_DRAIN = false;
    unsigned char* ws;
    __device__ __forceinline__ void operator()(const f32x4 (&acc)[2][2][4][2], const pg8::Unit& u, int wr, int wc, int fr, int fq) const {
        const int pn = u.pn, row0 = u.pm * 256 + wr * 64 + fr;
        if (pn <= 8) {
            bf16_t* dst; bf16_t* raw = nullptr; int ld, hcol;
            if (pn <= 1) { dst = (bf16_t*)(ws + WS_QAT); raw = (bf16_t*)(ws + WS_QAR); ld = 512; hcol = (pn * 4 + wc) * 64; }
            else if (pn == 2) { dst = (bf16_t*)(ws + (wc < 2 ? WS_KS : WS_KW)); ld = 128; hcol = (wc & 1) * 64; }
            else if (pn <= 5) { dst = (bf16_t*)(ws + WS_QB); ld = 768; hcol = ((pn - 3) * 4 + wc) * 64; }
            else { dst = (bf16_t*)(ws + WS_KB); ld = 768; hcol = ((pn - 6) * 4 + wc) * 64; }
            const float* ct = (const float*)(ws + WS_COS); const float* st = (const float*)(ws + WS_SIN);
#pragma unroll
            for (int ai = 0; ai < 2; ++ai)
#pragma unroll
                for (int m = 0; m < 4; ++m) {
                    const int row = row0 + ai * 128 + m * 16;
                    const f32x4 c0 = *(const f32x4*)(ct + row * 32 + 8 * fq), c1 = *(const f32x4*)(ct + row * 32 + 8 * fq + 4);
                    const f32x4 s0 = *(const f32x4*)(st + row * 32 + 8 * fq), s1 = *(const f32x4*)(st + row * 32 + 8 * fq + 4);
                    const f32x4 a0 = acc[ai][0][m][0], a1 = acc[ai][0][m][1], b0 = acc[ai][1][m][0], b1 = acc[ai][1][m][1];
                    const f32x4 o10 = a0 * c0 - b0 * s0, o11 = a1 * c1 - b1 * s1, o20 = b0 * c0 + a0 * s0, o21 = b1 * c1 + a1 * s1;
                    bf16_t* p = dst + (size_t)row * ld + hcol + 8 * fq;
                    u32x4 w; w.x = pk2(o10[0], o10[1]); w.y = pk2(o10[2], o10[3]); w.z = pk2(o11[0], o11[1]); w.w = pk2(o11[2], o11[3]); *(u32x4*)p = w;
                    w.x = pk2(o20[0], o20[1]); w.y = pk2(o20[2], o20[3]); w.z = pk2(o21[0], o21[1]); w.w = pk2(o21[2], o21[3]); *(u32x4*)(p + 32) = w;
                    if (raw) { bf16_t* q = raw + (size_t)row * ld + hcol + 8 * fq;
                        w.x = pk2(a0[0], a0[1]); w.y = pk2(a0[2], a0[3]); w.z = pk2(a1[0], a1[1]); w.w = pk2(a1[2], a1[3]); *(u32x4*)q = w;
                        w.x = pk2(b0[0], b0[1]); w.y = pk2(b0[2], b0[3]); w.z = pk2(b1[0], b1[1]); w.w = pk2(b1[2], b1[3]); *(u32x4*)(q + 32) = w; }
                }
        } else if (pn <= 29) {
            const int act = pn <= 13 ? 0 : (pn <= 17 ? 1 : 2);
#pragma unroll
            for (int bj = 0; bj < 2; ++bj) {
                bf16_t* dst; int ld, c0;
                if (pn == 9) { dst = (bf16_t*)(ws + (bj ? WS_VC : WS_KC)); ld = 128; c0 = 0; }
                else if (pn == 10) { dst = (bf16_t*)(ws + (bj ? WS_VW : WS_VS)); ld = 128; c0 = 0; }
                else if (pn <= 13) { dst = (bf16_t*)(ws + WS_VB); ld = 768; c0 = (pn - 11) * 256 + bj * 128; }
                else if (pn <= 17) { dst = (bf16_t*)(ws + WS_UVG); ld = 1024; c0 = (pn - 14) * 256 + bj * 128; }
                else { dst = (bf16_t*)(ws + WS_GM); ld = 3072; c0 = (pn - 18) * 256 + bj * 128; }
                c0 += wc * 32 + 8 * fq;
#pragma unroll
                for (int ai = 0; ai < 2; ++ai)
#pragma unroll
                    for (int m = 0; m < 4; ++m) {
                        const int row = row0 + ai * 128 + m * 16;
                        float v[8];
#pragma unroll
                        for (int n = 0; n < 2; ++n)
#pragma unroll
                            for (int i = 0; i < 4; ++i) { const float x = acc[ai][bj][m][n][i]; v[4 * n + i] = act == 0 ? x : (act == 1 ? gelu_tanh(x) : sigmoidf_(x)); }
                        u32x4 w; w.x = pk2(v[0], v[1]); w.y = pk2(v[2], v[3]); w.z = pk2(v[4], v[5]); w.w = pk2(v[6], v[7]);
                        *(u32x4*)(dst + (size_t)row * ld + c0) = w;
                    }
            }
        } else {
            if (wc == 0 && fq < 3) {
                float* ga = (float*)(ws + WS_GA);
#pragma unroll
                for (int ai = 0; ai < 2; ++ai)
#pragma unroll
                    for (int m = 0; m < 4; ++m) {
                        const int row = row0 + ai * 128 + m * 16;
#pragma unroll
                        for (int n = 0; n < 2; ++n) { const f32x4 x = acc[ai][0][m][n];
                            *(f32x4*)(ga + (size_t)row * 24 + 8 * fq + 4 * n) = (f32x4){sigmoidf_(x[0]), sigmoidf_(x[1]), sigmoidf_(x[2]), sigmoidf_(x[3])}; }
                    }
            }
        }
    }
};

__device__ __forceinline__ int win_col0(int dg) {
    const int pn = dg >> 3, q = dg & 7, hs = q & 3, half = q >> 2;
    if (pn <= 1) return (pn * 4 + hs) * 64 + 32 * half;
    if (pn == 2) return (hs == 0 ? 768 : hs == 1 ? 832 : hs == 2 ? 1024 : 1088) + 32 * half;
    if (pn <= 5) return 1304 + ((pn - 3) * 4 + hs) * 64 + 32 * half;
    if (pn <= 8) return 2072 + ((pn - 6) * 4 + hs) * 64 + 32 * half;
    if (pn == 9) return (q < 4 ? 512 : 640) + 32 * (q & 3);
    if (pn == 10) return (q < 4 ? 896 : 1152) + 32 * (q & 3);
    if (pn <= 13) return 2840 + (pn - 11) * 256 + 32 * q;
    if (pn <= 17) return 3608 + (pn - 14) * 256 + 32 * q;
    if (pn <= 29) return 4632 + (pn - 18) * 256 + 32 * q;
    return q == 0 ? 1280 : -1;
}

__device__ __forceinline__ void transpose_item(const float* W, int ldw, int col0, int k0, bf16_t* dst, int K, LAS float* scr, int lane) {
    if (col0 >= 0) {
#pragma unroll 8
        for (int i = 0; i < 32; ++i) { const int kk = 2 * i + (lane >> 5); scr[kk * 33 + (lane & 31)] = W[(size_t)(k0 + kk) * ldw + col0 + (lane & 31)]; }
    } else {
#pragma unroll 8
        for (int i = 0; i < 32; ++i) { const int kk = 2 * i + (lane >> 5); scr[kk * 33 + (lane & 31)] = 0.f; }
    }
    asm volatile("s_waitcnt lgkmcnt(0)" ::: "memory");
    const int c = lane & 7;
#pragma unroll
    for (int j = 0; j < 4; ++j) { const int n = (lane >> 3) + 8 * j; const LAS float* s = scr + (8 * c) * 33 + n;
        u32x4 o; o.x = pk2(s[0 * 33], s[1 * 33]); o.y = pk2(s[2 * 33], s[3 * 33]); o.z = pk2(s[4 * 33], s[5 * 33]); o.w = pk2(s[6 * 33], s[7 * 33]);
        *(u32x4*)(dst + (size_t)n * K + 8 * c) = o; }
    asm volatile("s_waitcnt lgkmcnt(0)" ::: "memory");
}

__device__ __forceinline__ void prologue_phase(ArgsP a, int l, LAS unsigned char* lds, int tid, int bid, int G) {
    const int lane = tid & 63, wave = tid >> 6;
    LAS float* scr = (LAS float*)(lds + wave * 16384);
    unsigned char* ws = a->ws;
    const int gw = bid * 8 + wave, NGW = G * 8;
    const float* g1 = a->in[3] + (size_t)l * D * FF; const float* u1 = a->in[4] + (size_t)l * D * FF; const float* d1 = a->in[5] + (size_t)l * FF * D;
    const float* g2 = a->in[6] + (size_t)l * D * FF; const float* u2 = a->in[7] + (size_t)l * D * FF; const float* d2 = a->in[8] + (size_t)l * FF * D;
    const float* win = a->in[9] + (size_t)l * D * INC;
    const float* pkw1 = a->in[11] + (size_t)l * 2048 * 128; const float* pkw2 = a->in[12] + (size_t)l * 128 * 64;
    const float* pvw1 = a->in[14] + (size_t)l * 2048 * 128; const float* pvw2 = a->in[15] + (size_t)l * 128 * 64;
    const float* wa = a->in[20] + (size_t)l * 512 * D; const float* wb = a->in[21] + (size_t)l * 256 * D; const float* wc = a->in[22] + (size_t)l * 512 * D; const float* wo = a->in[23] + (size_t)l * D * D;
    constexpr int I_GU = 16 * 176, I_D = 44 * 32, I_IN = 16 * 248, I_A = 8 * 32, I_B = 4 * 32, I_O = 16 * 32, I_P1 = 32 * 4, I_P2 = 2 * 2;
    constexpr int NIT = 2 * I_GU + 2 * I_D + I_IN + 2 * I_A + I_B + I_O + 2 * I_P1 + 2 * I_P2;
    for (int it = gw; it < NIT; it += NGW) {
        int r = it; const float* src; int ldw, col0, kb, dg, K; size_t dbase;
        if (r < 2 * I_GU) { const int f = r >= I_GU; if (f) r -= I_GU; kb = r / 176; dg = r % 176; const int pn = dg >> 3, q = dg & 7;
            src = (q < 4) ? (f ? g2 : g1) : (f ? u2 : u1); ldw = FF; col0 = 128 * pn + 32 * (q & 3); K = 1024; dbase = f ? W_GU2 : W_GU1; }
        else if ((r -= 2 * I_GU) < 2 * I_D) { const int f = r >= I_D; if (f) r -= I_D; kb = r / 32; dg = r % 32; src = f ? d2 : d1; ldw = D; col0 = 32 * dg; K = FF; dbase = f ? W_D2 : W_D1; }
        else if ((r -= 2 * I_D) < I_IN) { kb = r / 248; dg = r % 248; src = win; ldw = INC; col0 = win_col0(dg); K = 1024; dbase = W_IN; }
        else if ((r -= I_IN) < I_A) { kb = r / 32; dg = r % 32; src = wa; ldw = D; col0 = 32 * dg; K = 512; dbase = W_A; }
        else if ((r -= I_A) < I_A) { kb = r / 32; dg = r % 32; src = wc; ldw = D; col0 = 32 * dg; K = 512; dbase = W_C; }
        else if ((r -= I_A) < I_B) { kb = r / 32; dg = r % 32; src = wb; ldw = D; col0 = 32 * dg; K = 256; dbase = W_B; }
        else if ((r -= I_B) < I_O) { kb = r / 32; dg = r % 32; src = wo; ldw = D; col0 = 32 * dg; K = 1024; dbase = W_O; }
        else if ((r -= I_O) < 2 * I_P1) { const int f = r >= I_P1; if (f) r -= I_P1; kb = r / 4; dg = r % 4; src = f ? pvw1 : pkw1; ldw = 128; col0 = 32 * dg; K = 2048; dbase = f ? W_P1V : W_P1K; }
        else { r -= 2 * I_P1; const int f = r >= I_P2; if (f) r -= I_P2; kb = r / 2; dg = r % 2; src = f ? pvw2 : pkw2; ldw = 64; col0 = 32 * dg; K = 128; dbase = f ? W_P2V : W_P2K; }
        transpose_item(src, ldw, col0, kb * 64, (bf16_t*)(ws + dbase) + (size_t)dg * 32 * K + kb * 64, K, scr, lane);
    }
    { const float* sw = a->in[18] + (size_t)l * 4 * 128 * 128; bf16_t* o = (bf16_t*)(ws + W_SGU);
      for (int i = bid * NTHR + tid; i < 4 * 128 * 128; i += G * NTHR) { const int t = (i >> 7) & 127, s = i & 127; o[i] = (bf16_t)f2bf(s <= t ? sw[i] : 0.f); } }
    for (int o = gw; o < 256; o += NGW) {
        const int which = o >> 7, c = o & 127;
        const float* pos = a->in[which ? 13 : 10] + (size_t)l * 2048; const float* w1 = which ? pvw1 : pkw1;
        float s = 0.f;
        for (int kk = lane; kk < 2048; kk += 64) s += pos[kk] * w1[(size_t)kk * 128 + c];
        s = wave_sum(s);
        if (lane == 0) ((float*)(ws + W_PB))[o] = s;
    }
    if (l == 0) {
        const f32x4* x4 = (const f32x4*)a->in[0]; u32x2* xb = (u32x2*)(ws + WS_XB);
        for (size_t i = (size_t)bid * NTHR + tid; i < (size_t)S * D / 4; i += (size_t)G * NTHR) { const f32x4 v = x4[i]; u32x2 w; w.x = pk2(v[0], v[1]); w.y = pk2(v[2], v[3]); xb[i] = w; }
        float* ct = (float*)(ws + WS_COS); float* st = (float*)(ws + WS_SIN);
        for (int i = bid * NTHR + tid; i < S * 32; i += G * NTHR) {
            const int t = i >> 5, d = i & 31;
            const float angf = (float)t * a->inv[d];
            const double ang = (double)angf;
            const double kq = rint(ang * 0.63661977236758134308);
            const double rr = (ang - kq * 1.57079632673412561417) - kq * 6.07710050650619224932e-11;
            const double r2 = rr * rr;
#define DC(x) ([](double v_) { asm volatile("" : "+s"(v_)); return v_; }(x))
            double sn = DC(1.0 / 6227020800.0); sn = sn * r2 + DC(-1.0 / 39916800); sn = sn * r2 + DC(1.0 / 362880); sn = sn * r2 + DC(-1.0 / 5040); sn = sn * r2 + DC(1.0 / 120); sn = sn * r2 + DC(-1.0 / 6); sn = rr + rr * r2 * sn;
            double cs = DC(-1.0 / 87178291200.0); cs = cs * r2 + DC(1.0 / 479001600); cs = cs * r2 + DC(-1.0 / 3628800); cs = cs * r2 + DC(1.0 / 40320); cs = cs * r2 + DC(-1.0 / 720); cs = cs * r2 + DC(1.0 / 24); cs = cs * r2 + DC(-0.5); cs = 1.0 + r2 * cs;
#undef DC
            const int qd = ((int)kq) & 3;
            const double c = qd == 0 ? cs : qd == 1 ? -sn : qd == 2 ? -cs : sn;
            const double s = qd == 0 ? sn : qd == 1 ? cs : qd == 2 ? -sn : -cs;
            ct[i] = (float)c; st[i] = (float)s;
        }
    }
}

__device__ __forceinline__ void ln_phase(const float* V, const float* gam, const float* bet, float* X, bf16_t* XB, int tid, int bid, int G) {
    const int lane = tid & 63, wave = tid >> 6;
    const int gw = bid * 8 + wave, NGW = G * 8;
    f32x4 gv[4], bv[4];
#pragma unroll
    for (int j = 0; j < 4; ++j) { gv[j] = ((const f32x4*)gam)[64 * j + lane]; bv[j] = ((const f32x4*)bet)[64 * j + lane]; }
    for (int m = gw; m < S; m += NGW) {
        const f32x4* xr = (const f32x4*)(V + (size_t)m * D) + lane;
        f32x4 v[4]; float s = 0.f;
#pragma unroll
        for (int j = 0; j < 4; ++j) { v[j] = xr[64 * j]; s += (v[j][0] + v[j][1]) + (v[j][2] + v[j][3]); }
        const float mean = wave_sum(s) * (1.f / D); float s2 = 0.f;
#pragma unroll
        for (int j = 0; j < 4; ++j) { v[j] = v[j] - mean; s2 += (v[j][0] * v[j][0] + v[j][1] * v[j][1]) + (v[j][2] * v[j][2] + v[j][3] * v[j][3]); }
        const float rstd = 1.0f / sqrtf(wave_sum(s2) * (1.f / D) + LN_EPS);
        f32x4* xo = (f32x4*)(X + (size_t)m * D) + lane; u32x2* bo = (u32x2*)(XB + (size_t)m * D) + lane;
#pragma unroll
        for (int j = 0; j < 4; ++j) { const f32x4 y = v[j] * rstd * gv[j] + bv[j]; xo[64 * j] = y; u32x2 w; w.x = pk2(y[0], y[1]); w.y = pk2(y[2], y[3]); bo[64 * j] = w; }
    }
}

constexpr int RP = 144;
struct KFrag { bf16x8 a0, a1, b0, b1; };
__device__ __forceinline__ KFrag load_kfrag(LAS const unsigned char* Kt, int lane) {
    const int r = lane & 15, g = lane >> 4;
    LAS const unsigned char* ka = Kt + (8 * (r >> 2) + (r & 3)) * RP + g * 16;
    KFrag k; k.a0 = *(LAS const bf16x8*)ka; k.a1 = *(LAS const bf16x8*)(ka + 64); k.b0 = *(LAS const bf16x8*)(ka + 4 * RP); k.b1 = *(LAS const bf16x8*)(ka + 4 * RP + 64);
    return k;
}
__device__ __forceinline__ void load_vfrag(bf16x8 (&vf)[4], LAS const unsigned char* Vt, int lane) {
    const int r = lane & 15, g = lane >> 4;
    LAS const unsigned char* vb = Vt + (8 * g + (r >> 2)) * RP + (lane & 3) * 8;
#pragma unroll
    for (int c = 0; c < 4; ++c) vf[c] = cat8(tr_read(vb + c * 32), tr_read(vb + 4 * RP + c * 32));
}
__device__ __forceinline__ void scores8(float (&s)[8], const KFrag& k, const bf16x8 (&qf)[2]) {
    const f32x4 z = {0.f, 0.f, 0.f, 0.f};
    f32x4 sa = mfma16(k.a0, qf[0], z); sa = mfma16(k.a1, qf[1], sa);
    f32x4 sb = mfma16(k.b0, qf[0], z); sb = mfma16(k.b1, qf[1], sb);
    s[0] = sa[0]; s[1] = sa[1]; s[2] = sa[2]; s[3] = sa[3]; s[4] = sb[0]; s[5] = sb[1]; s[6] = sb[2]; s[7] = sb[3];
}
__device__ __forceinline__ float rmax4(float v) { v = fmaxf(v, __shfl_xor(v, 16)); return fmaxf(v, __shfl_xor(v, 32)); }
__device__ __forceinline__ float rsum4(float v) { v += __shfl_xor(v, 16); return v + __shfl_xor(v, 32); }

__device__ __forceinline__ void attn_tile_step(float& m, float& l, f32x4 (&o)[4], const bf16x8 (&qf)[2], const KFrag& k, const bf16x8 (&vf)[4], unsigned vmask) {
    float s[8]; scores8(s, k, qf);
    float mx = -1e30f;
#pragma unroll
    for (int e = 0; e < 8; ++e) { s[e] = ((vmask >> e) & 1u) ? s[e] * QK_SC : -1e30f; mx = fmaxf(mx, s[e]); }
    mx = rmax4(mx);
    const float mn = fmaxf(m, mx), corr = fexp2(m - mn);
    float p[8], rs = 0.f;
#pragma unroll
    for (int e = 0; e < 8; ++e) { p[e] = ((vmask >> e) & 1u) ? fexp2(s[e] - mn) : 0.f; rs += p[e]; }
    rs = rsum4(rs);
    l = l * corr + rs; m = mn;
    const bf16x8 pf = pack8(p);
#pragma unroll
    for (int c = 0; c < 4; ++c) { o[c] = o[c] * corr; o[c] = mfma16(vf[c], pf, o[c]); }
}

__device__ __forceinline__ void win_phase(unsigned char* ws, LAS unsigned char* lds, int tid, int bid, int G) {
    const int lane = tid & 63, wave = tid >> 6, r = lane & 15, g = lane >> 4;
    const bf16_t* Q = (const bf16_t*)(ws + WS_QAT); const bf16_t* Kg = (const bf16_t*)(ws + WS_KW); const bf16_t* Vg = (const bf16_t*)(ws + WS_VW);
    const float* GA = (const float*)(ws + WS_GA); float* OA32 = (float*)(ws + WS_OA32);
    LAS unsigned char* Kl = lds; LAS unsigned char* Vl = lds + 128 * RP;
    for (int u = bid; u < 512; u += G) {
        const int tile = u >> 1, grp = u & 1, t0 = tile * 64;
        const int kstart = t0 >= 512 ? t0 - 512 : 0, kend = t0 + 64;
        const int tw = t0 + 8 * wave;
        bf16x8 qf[2][2]; float m[2], l[2]; f32x4 o[2][4];
#pragma unroll
        for (int qt = 0; qt < 2; ++qt) {
            const int tok = tw + 4 * qt + (r >> 2), head = r & 3;
            const bf16_t* qp = Q + (size_t)tok * 512 + (grp * 4 + head) * 64 + 8 * g;
            qf[qt][0] = *(const bf16x8*)qp; qf[qt][1] = *(const bf16x8*)(qp + 32);
            m[qt] = -1e30f; l[qt] = 0.f;
#pragma unroll
            for (int c = 0; c < 4; ++c) o[qt][c] = (f32x4){0.f, 0.f, 0.f, 0.f};
        }
        for (int kc = kstart; kc < kend; kc += 128) {
            const int nrows = (kend - kc) < 128 ? (kend - kc) : 128;
            __syncthreads();
            for (int c = tid; c < nrows * 8; c += NTHR) { const int i = c >> 3, pc = c & 7;
                *(LAS u32x4*)(Kl + i * RP + pc * 16) = *(const u32x4*)(Kg + (size_t)(kc + i) * 128 + grp * 64 + pc * 8);
                *(LAS u32x4*)(Vl + i * RP + pc * 16) = *(const u32x4*)(Vg + (size_t)(kc + i) * 128 + grp * 64 + pc * 8); }
            __syncthreads();
            for (int st = 0; st < nrows / 32; ++st) {
                const int k0 = kc + 32 * st;
                if (k0 + 31 < tw - 511 || k0 > tw + 7) continue;
                const KFrag kf = load_kfrag(Kl + st * 32 * RP, lane);
                bf16x8 vf[4]; load_vfrag(vf, Vl + st * 32 * RP, lane);
#pragma unroll
                for (int qt = 0; qt < 2; ++qt) {
                    const int t = tw + 4 * qt + (r >> 2); unsigned vm = 0;
#pragma unroll
                    for (int e = 0; e < 8; ++e) { const int dlt = t - (k0 + 8 * g + e); vm |= (dlt >= 0 && dlt < 512) ? (1u << e) : 0u; }
                    attn_tile_step(m[qt], l[qt], o[qt], qf[qt], kf, vf, vm);
                }
            }
        }
#pragma unroll
        for (int qt = 0; qt < 2; ++qt) {
            const int tok = tw + 4 * qt + (r >> 2), head = r & 3, hh = grp * 4 + head;
            const float sc = GA[(size_t)tok * 24 + hh * 3 + 2] / fmaxf(l[qt], 1e-30f);
#pragma unroll
            for (int c = 0; c < 4; ++c) *(f32x4*)(OA32 + (size_t)tok * 512 + hh * 64 + 16 * c + 4 * g) = o[qt][c] * sc;
        }
    }
}

__device__ __forceinline__ void dil_phase(unsigned char* ws, LAS unsigned char* lds, int tid, int bid, int G) {
    const int lane = tid & 63, wave = tid >> 6, r = lane & 15, g = lane >> 4;
    const bf16_t* Q = (const bf16_t*)(ws + WS_QB); const bf16_t* Kg = (const bf16_t*)(ws + WS_KB); const bf16_t* Vg = (const bf16_t*)(ws + WS_VB);
    bf16_t* OD = (bf16_t*)(ws + WS_OD); float* LSE = (float*)(ws + WS_LSE);
    LAS unsigned char* Kl = lds; LAS unsigned char* Vl = lds + 256 * RP;
    for (int u = bid; u < 1536; u += G) {
        const int h = u >> 7, rem = u & 127, gi = h >> 2, hi = h & 3, dil = 1 << (2 * gi), nsub = 128 >> (2 * gi), rr = rem / nsub, n = rem % nsub;
        const int mbase = 128 * n - 128;
        __syncthreads();
        for (int c = tid; c < 256 * 8; c += NTHR) { const int i = c >> 3, pc = c & 7; const int mk = mbase + i;
            u32x4 kv = {0, 0, 0, 0}, vv = {0, 0, 0, 0};
            if (mk >= 0) { const size_t off = (size_t)(mk * dil + rr) * 768 + h * 64 + pc * 8; kv = *(const u32x4*)(Kg + off); vv = *(const u32x4*)(Vg + off); }
            *(LAS u32x4*)(Kl + i * RP + pc * 16) = kv; *(LAS u32x4*)(Vl + i * RP + pc * 16) = vv; }
        __syncthreads();
        const int mq = 128 * n + 16 * wave + r, tq = mq * dil + rr;
        bf16x8 qf[2]; { const bf16_t* qp = Q + (size_t)tq * 768 + h * 64 + 8 * g; qf[0] = *(const bf16x8*)qp; qf[1] = *(const bf16x8*)(qp + 32); }
        float m = -1e30f, l = 0.f; f32x4 o[4];
#pragma unroll
        for (int c = 0; c < 4; ++c) o[c] = (f32x4){0.f, 0.f, 0.f, 0.f};
        const int start = (16 * wave) & ~31;
        for (int st = 0; st < 5; ++st) {
            const int i0 = start + 32 * st;
            const KFrag kf = load_kfrag(Kl + i0 * RP, lane);
            bf16x8 vf[4]; load_vfrag(vf, Vl + i0 * RP, lane);
            unsigned vm = 0;
#pragma unroll
            for (int e = 0; e < 8; ++e) { const int mk = mbase + i0 + 8 * g + e; const int dlt = mq - mk; vm |= (dlt >= 0 && dlt <= 128 && mk >= 0) ? (1u << e) : 0u; }
            attn_tile_step(m, l, o, qf, kf, vf, vm);
        }
        const float il = 1.0f / fmaxf(l, 1e-30f);
        bf16_t* op = OD + ((size_t)gi * S + tq) * 256 + hi * 64 + 4 * g;
#pragma unroll
        for (int c = 0; c < 4; ++c) { u32x2 w; w.x = pk2(o[c][0] * il, o[c][1] * il); w.y = pk2(o[c][2] * il, o[c][3] * il); *(u32x2*)(op + 16 * c) = w; }
        if (g == 0) LSE[((size_t)gi * S + tq) * 4 + hi] = m + log2f(fmaxf(l, 1e-30f));
    }
}
__device__ __forceinline__ void dil_combine(unsigned char* ws, int tid, int bid, int G) {
    const bf16_t* OD = (const bf16_t*)(ws + WS_OD); const float* LSE = (const float*)(ws + WS_LSE); bf16_t* OB = (bf16_t*)(ws + WS_OB);
    for (int i = bid * NTHR + tid; i < S * 32; i += G * NTHR) {
        const int t = i >> 5, hi = (i >> 3) & 3, ch = i & 7;
        const float l0 = LSE[(size_t)t * 4 + hi], l1 = LSE[((size_t)S + t) * 4 + hi], l2 = LSE[((size_t)2 * S + t) * 4 + hi];
        const float mx = fmaxf(l0, fmaxf(l1, l2));
        float w0 = fexp2(l0 - mx), w1 = fexp2(l1 - mx), w2 = fexp2(l2 - mx); const float iw = 1.0f / (w0 + w1 + w2); w0 *= iw; w1 *= iw; w2 *= iw;
        const size_t off = (size_t)t * 256 + hi * 64 + ch * 8;
        const u32x4 a = *(const u32x4*)(OD + off), b = *(const u32x4*)(OD + (size_t)S * 256 + off), c = *(const u32x4*)(OD + (size_t)2 * S * 256 + off);
        u32x4 w;
        w.x = pk2(w0 * bflo(a.x) + w1 * bflo(b.x) + w2 * bflo(c.x), w0 * bfhi(a.x) + w1 * bfhi(b.x) + w2 * bfhi(c.x));
        w.y = pk2(w0 * bflo(a.y) + w1 * bflo(b.y) + w2 * bflo(c.y), w0 * bfhi(a.y) + w1 * bfhi(b.y) + w2 * bfhi(c.y));
        w.z = pk2(w0 * bflo(a.z) + w1 * bflo(b.z) + w2 * bflo(c.z), w0 * bfhi(a.z) + w1 * bfhi(b.z) + w2 * bfhi(c.z));
        w.w = pk2(w0 * bflo(a.w) + w1 * bflo(b.w) + w2 * bflo(c.w), w0 * bfhi(a.w) + w1 * bfhi(b.w) + w2 * bfhi(c.w));
        *(u32x4*)(OB + off) = w;
    }
}

__device__ __forceinline__ void sgu_phase(ArgsP a, unsigned char* ws, int l, LAS unsigned char* lds, int tid, int bid, int G) {
    constexpr int VRP = 272;
    const int lane = tid & 63, wave = tid >> 6, r = lane & 15, g = lane >> 4;
    const bf16_t* UVG = (const bf16_t*)(ws + WS_UVG); bf16_t* OC = (bf16_t*)(ws + WS_OC); const bf16_t* WSB = (const bf16_t*)(ws + W_SGU);
    const float* lng = a->in[16] + (size_t)l * 512; const float* lnb = a->in[17] + (size_t)l * 512; const float* sb = a->in[19] + (size_t)l * 512;
    LAS unsigned char* vh = lds;
    for (int u = bid; u < 512; u += G) {
        const int n = u >> 2, grp = u & 3, t0 = n * 128;
        __syncthreads();
        for (int tt = 0; tt < 16; ++tt) {
            const int tl = 16 * wave + tt;
            const u32x4 w = *(const u32x4*)(UVG + (size_t)(t0 + tl) * 1024 + 512 + 8 * lane);
            float v[8] = {bflo(w.x), bfhi(w.x), bflo(w.y), bfhi(w.y), bflo(w.z), bfhi(w.z), bflo(w.w), bfhi(w.w)};
            float s = 0.f;
#pragma unroll
            for (int e = 0; e < 8; ++e) s += v[e];
            const float mean = wave_sum(s) * (1.f / 512); float s2 = 0.f;
#pragma unroll
            for (int e = 0; e < 8; ++e) { v[e] -= mean; s2 += v[e] * v[e]; }
            const float rstd = 1.0f / sqrtf(wave_sum(s2) * (1.f / 512) + LN_EPS);
            if ((lane >> 4) == grp) {
                float y[8];
#pragma unroll
                for (int e = 0; e < 8; ++e) y[e] = v[e] * rstd * lng[8 * lane + e] + lnb[8 * lane + e];
                u32x4 o; o.x = pk2(y[0], y[1]); o.y = pk2(y[2], y[3]); o.z = pk2(y[4], y[5]); o.w = pk2(y[6], y[7]);
                *(LAS u32x4*)(vh + tl * VRP + (8 * lane - 128 * grp) * 2) = o;
            }
        }
        __syncthreads();
        f32x4 acc[8];
#pragma unroll
        for (int c = 0; c < 8; ++c) acc[c] = (f32x4){0.f, 0.f, 0.f, 0.f};
        const int nst = (16 * wave + 15) / 32 + 1;
        for (int ks = 0; ks < nst; ++ks) {
            const bf16x8 bfr = *(const bf16x8*)(WSB + ((size_t)grp * 128 + 16 * wave + r) * 128 + 32 * ks + 8 * g);
            LAS const unsigned char* vb = vh + (32 * ks + 8 * g + (r >> 2)) * VRP + (lane & 3) * 8;
#pragma unroll
            for (int c = 0; c < 8; ++c) { const bf16x8 af = cat8(tr_read(vb + c * 32), tr_read(vb + 4 * VRP + c * 32)); acc[c] = mfma16(af, bfr, acc[c]); }
        }
        const int tl = 16 * wave + r; const float bias = sb[grp * 128 + tl];
        const bf16_t* up = UVG + (size_t)(t0 + tl) * 1024 + grp * 128 + 4 * g; bf16_t* op = OC + (size_t)(t0 + tl) * 512 + grp * 128 + 4 * g;
#pragma unroll
        for (int c = 0; c < 8; ++c) { const u32x2 uw = *(const u32x2*)(up + 16 * c);
            u32x2 w; w.x = pk2(bflo(uw.x) * (acc[c][0] + bias), bfhi(uw.x) * (acc[c][1] + bias)); w.y = pk2(bflo(uw.y) * (acc[c][2] + bias), bfhi(uw.y) * (acc[c][3] + bias));
            *(u32x2*)(op + 16 * c) = w; }
    }
}

__device__ __forceinline__ void cmp_mlp_phase(unsigned char* ws, LAS unsigned char* lds, int tid, int bid, int G) {
    const int lane = tid & 63, wave = tid >> 6, r = lane & 15, g = lane >> 4;
    LAS float* red = (LAS float*)lds; LAS unsigned char* hid = lds + 65536;
    for (int u = bid; u < 256; u += G) {
        const int which = u >> 7, grp = (u >> 6) & 1, rt = u & 63;
        const bf16_t* src = (const bf16_t*)(ws + (which ? WS_VC : WS_KC)); const bf16_t* w1t = (const bf16_t*)(ws + (which ? W_P1V : W_P1K)); const bf16_t* w2t = (const bf16_t*)(ws + (which ? W_P2V : W_P2K));
        const float* pb = (const float*)(ws + W_PB) + which * 128; bf16_t* dst = (bf16_t*)(ws + (which ? WS_VCMP : WS_KCMP));
        f32x4 acc[8];
#pragma unroll
        for (int c = 0; c < 8; ++c) acc[c] = (f32x4){0.f, 0.f, 0.f, 0.f};
        for (int ks = 0; ks < 8; ++ks) {
            const int j = 4 * wave + (ks >> 1), d0 = (ks & 1) * 32 + 8 * g, tok = 16 * (16 * rt + r) + j;
            bf16x8 af = {0, 0, 0, 0, 0, 0, 0, 0};
            if (tok < S) af = *(const bf16x8*)(src + (size_t)tok * 128 + grp * 64 + d0);
#pragma unroll
            for (int c = 0; c < 8; ++c) { const bf16x8 bfr = *(const bf16x8*)(w1t + (size_t)(16 * c + r) * 2048 + 256 * wave + 32 * ks + 8 * g); acc[c] = mfma16(af, bfr, acc[c]); }
        }
        __syncthreads();
#pragma unroll
        for (int c = 0; c < 8; ++c)
#pragma unroll
            for (int i = 0; i < 4; ++i) red[wave * 2048 + (4 * g + i) * 128 + 16 * c + r] = acc[c][i];
        __syncthreads();
#pragma unroll
        for (int q = 0; q < 4; ++q) { const int idx = tid * 4 + q, row = idx >> 7, col = idx & 127; float s = pb[col];
#pragma unroll
            for (int w = 0; w < 8; ++w) s += red[w * 2048 + idx];
            *(LAS bf16_t*)(hid + row * 272 + col * 2) = (bf16_t)f2bf(gelu_tanh(s)); }
        __syncthreads();
        if (wave < 4) {
            f32x4 a2 = {0.f, 0.f, 0.f, 0.f};
#pragma unroll
            for (int ks = 0; ks < 4; ++ks) { const bf16x8 af = *(LAS const bf16x8*)(hid + r * 272 + (32 * ks + 8 * g) * 2); const bf16x8 bfr = *(const bf16x8*)(w2t + (size_t)(16 * wave + r) * 128 + 32 * ks + 8 * g); a2 = mfma16(af, bfr, a2); }
#pragma unroll
            for (int i = 0; i < 4; ++i) dst[((size_t)grp * 1024 + 16 * rt + 4 * g + i) * 64 + 16 * wave + r] = (bf16_t)f2bf(a2[i]);
        }
    }
}

__device__ __forceinline__ void cmp_attn_phase(unsigned char* ws, LAS unsigned char* lds, int tid, int bid, int G) {
    const int lane = tid & 63, wave = tid >> 6, r = lane & 15, g = lane >> 4;
    const bf16_t* Q = (const bf16_t*)(ws + WS_QAR); const float* GA = (const float*)(ws + WS_GA); const float* OA32 = (const float*)(ws + WS_OA32); float* OA32B = (float*)(ws + WS_OA32B); unsigned* SEL = (unsigned*)(ws + WS_SEL);
    LAS unsigned char* Kl = lds; LAS unsigned char* Vl = lds + 128 * RP; LAS float* pslc = (LAS float*)(lds + 65536);
    for (int u = bid; u < 1024; u += G) {
        const int ux = (u & 255) >> 1, uk = u >> 8, tile = uk == 0 ? ux : (uk == 1 ? 255 - ux : (uk == 2 ? 256 + ux : 511 - ux)), grp = u & 1, t0 = tile * 32;
        const bf16_t* Kg = (const bf16_t*)(ws + WS_KCMP) + (size_t)grp * 1024 * 64; const bf16_t* Vg = (const bf16_t*)(ws + WS_VCMP) + (size_t)grp * 1024 * 64;
        const int nk = t0 / 16 + 1;
        const int tokl = 4 * wave + (r >> 2), tok = t0 + tokl, head = r & 3, hh = grp * 4 + head;
        bf16x8 qf[2]; { const bf16_t* qp = Q + (size_t)tok * 512 + hh * 64 + 8 * g; qf[0] = *(const bf16x8*)qp; qf[1] = *(const bf16x8*)(qp + 32); }
        __syncthreads();
        for (int i = tid; i < 32 * 256; i += NTHR) pslc[i] = 0.f;
        float m = -1e30f, l = 0.f;
        const int crow = tid >> 3, cpc = tid & 7;
        u32x4 kr0, kr1, vr0, vr1;
        kr0 = *(const u32x4*)(Kg + (size_t)crow * 64 + cpc * 8); kr1 = *(const u32x4*)(Kg + (size_t)(crow + 64) * 64 + cpc * 8);
        for (int kc = 0; kc < nk; kc += 128) {
            __syncthreads();
            *(LAS u32x4*)(Kl + crow * RP + cpc * 16) = kr0; *(LAS u32x4*)(Kl + (crow + 64) * RP + cpc * 16) = kr1;
            __syncthreads();
            { const int kn = (kc + 128 < nk) ? kc + 128 : 0;
              kr0 = *(const u32x4*)(Kg + (size_t)(kn + crow) * 64 + cpc * 8); kr1 = *(const u32x4*)(Kg + (size_t)(kn + crow + 64) * 64 + cpc * 8); }
            const int nst = ((nk - kc) < 128 ? (nk - kc) : 128);
            for (int st = 0; st * 32 < nst; ++st) {
                const KFrag kf = load_kfrag(Kl + st * 32 * RP, lane);
                float s[8]; scores8(s, kf, qf);
                float mx = -1e30f; unsigned vm = 0;
#pragma unroll
                for (int e = 0; e < 8; ++e) { const int nn = kc + 32 * st + 8 * g + e; const bool ok = 16 * nn + 31 <= tok; vm |= ok ? (1u << e) : 0u; s[e] = ok ? s[e] * QK_SC : -1e30f; mx = fmaxf(mx, s[e]); }
                mx = rmax4(mx);
                const float mn = fmaxf(m, mx); float rs = 0.f;
#pragma unroll
                for (int e = 0; e < 8; ++e) rs += ((vm >> e) & 1u) ? fexp2(s[e] - mn) : 0.f;
                rs = rsum4(rs);
                l = l * fexp2(m - mn) + rs; m = mn;
            }
        }
        const float il = 1.0f / fmaxf(l, 1e-30f);
        f32x4 o[4];
#pragma unroll
        for (int c = 0; c < 4; ++c) o[c] = (f32x4){0.f, 0.f, 0.f, 0.f};
        vr0 = *(const u32x4*)(Vg + (size_t)crow * 64 + cpc * 8); vr1 = *(const u32x4*)(Vg + (size_t)(crow + 64) * 64 + cpc * 8);
        for (int kc = 0; kc < nk; kc += 128) {
            __syncthreads();
            *(LAS u32x4*)(Kl + crow * RP + cpc * 16) = kr0; *(LAS u32x4*)(Kl + (crow + 64) * RP + cpc * 16) = kr1;
            *(LAS u32x4*)(Vl + crow * RP + cpc * 16) = vr0; *(LAS u32x4*)(Vl + (crow + 64) * RP + cpc * 16) = vr1;
            __syncthreads();
            if (kc + 128 < nk) { const int kn = kc + 128;
              kr0 = *(const u32x4*)(Kg + (size_t)(kn + crow) * 64 + cpc * 8); kr1 = *(const u32x4*)(Kg + (size_t)(kn + crow + 64) * 64 + cpc * 8);
              vr0 = *(const u32x4*)(Vg + (size_t)(kn + crow) * 64 + cpc * 8); vr1 = *(const u32x4*)(Vg + (size_t)(kn + crow + 64) * 64 + cpc * 8); }
            const int nst = ((nk - kc) < 128 ? (nk - kc) : 128);
            for (int st = 0; st * 32 < nst; ++st) {
                const KFrag kf = load_kfrag(Kl + st * 32 * RP, lane);
                bf16x8 vf[4]; load_vfrag(vf, Vl + st * 32 * RP, lane);
                float s[8]; scores8(s, kf, qf);
                float p[8];
#pragma unroll
                for (int e = 0; e < 8; ++e) { const int nn = kc + 32 * st + 8 * g + e; const bool ok = 16 * nn + 31 <= tok; p[e] = ok ? fexp2(s[e] * QK_SC - m) * il : 0.f; }
                const bf16x8 pf = pack8(p);
#pragma unroll
                for (int c = 0; c < 4; ++c) o[c] = mfma16(vf[c], pf, o[c]);
                float A = (p[0] + p[1]) + (p[2] + p[3]), B = p[3] + (p[4] + p[5]) + (p[6] + p[7]), C = p[7];
                A += __shfl_xor(A, 1); A += __shfl_xor(A, 2); B += __shfl_xor(B, 1); B += __shfl_xor(B, 2); C += __shfl_xor(C, 1); C += __shfl_xor(C, 2);
                if ((lane & 3) == 0) {
                    const int j0 = (kc + 32 * st) / 4 + 2 * g; float* pp = (float*)(pslc + tokl * 256);
                    atomicAdd(pp + j0, A);
                    if (j0 + 1 < 256) atomicAdd(pp + j0 + 1, B);
                    if (j0 + 2 < 256) atomicAdd(pp + j0 + 2, C);
                }
            }
        }
        { const float sc = GA[(size_t)tok * 24 + hh * 3 + 0];
#pragma unroll
          for (int c = 0; c < 4; ++c) { const size_t off = (size_t)tok * 512 + hh * 64 + 16 * c + 4 * g; *(f32x4*)(OA32B + off) = *(const f32x4*)(OA32 + off) + o[c] * sc; } }
        __syncthreads();
        {
            const unsigned long long lt = (1ull << lane) - 1ull;
#pragma unroll
            for (int tk = 0; tk < 4; ++tk) {
                const int tl = 4 * wave + tk, t = t0 + tl, cur = t >> 6;
                unsigned key[4];
#pragma unroll
                for (int i = 0; i < 4; ++i) { const int j = lane + 64 * i;
                    key[i] = (j > cur) ? 0u : ((j == 0 || j == cur || j == cur - 1) ? 0x7f800000u : (__builtin_bit_cast(unsigned, pslc[tl * 256 + j]) + 1u)); }
                unsigned T = 0;
                for (int bit = 30; bit >= 0; --bit) {
                    const unsigned cand = T | (1u << bit);
                    const int cnt = __builtin_popcountll(__ballot(key[0] >= cand)) + __builtin_popcountll(__ballot(key[1] >= cand)) + __builtin_popcountll(__ballot(key[2] >= cand)) + __builtin_popcountll(__ballot(key[3] >= cand));
                    if (cnt >= 16) T = cand;
                }
                bool sel[4]; int c1 = 0;
#pragma unroll
                for (int i = 0; i < 4; ++i) { sel[i] = key[i] > T; c1 += __builtin_popcountll(__ballot(sel[i])); }
                if (T > 0u) { const int need = 16 - c1; int run = 0;
#pragma unroll
                    for (int i = 0; i < 4; ++i) { const bool eq = key[i] == T; const unsigned long long bm = __ballot(eq); const int rank = run + __builtin_popcountll(bm & lt); sel[i] = sel[i] || (eq && rank < need); run += __builtin_popcountll(bm); } }
#pragma unroll
                for (int i = 0; i < 4; ++i) { const unsigned long long bm = __ballot(sel[i]);
                    if (lane == 0) { SEL[((size_t)t * 2 + grp) * 8 + 2 * i] = (unsigned)bm; SEL[((size_t)t * 2 + grp) * 8 + 2 * i + 1] = (unsigned)(bm >> 32); } }
            }
        }
    }
}

__device__ __forceinline__ void slc_phase(unsigned char* ws, LAS unsigned char* lds, int tid, int bid, int G) {
    const int lane = tid & 63, wave = tid >> 6, r = lane & 15, g = lane >> 4;
    const bf16_t* Q = (const bf16_t*)(ws + WS_QAT); const bf16_t* Kg = (const bf16_t*)(ws + WS_KS); const bf16_t* Vg = (const bf16_t*)(ws + WS_VS);
    const float* GA = (const float*)(ws + WS_GA); const float* OA32 = (const float*)(ws + WS_OA32B); bf16_t* OA = (bf16_t*)(ws + WS_OA); const unsigned* SEL = (const unsigned*)(ws + WS_SEL);
    constexpr int KVB = 128 * RP;
    LAS unsigned* selm = (LAS unsigned*)(lds + 4 * KVB); LAS unsigned* uni = (LAS unsigned*)(lds + 4 * KVB + 2048); LAS unsigned* blist = (LAS unsigned*)(lds + 4 * KVB + 4096);
    for (int u = bid; u < 512; u += G) {
        const int ux = (u & 255) >> 1, tile = (u < 256) ? ux : 255 - ux, grp = u & 1, t0 = tile * 64, cur = tile;
        __syncthreads();
        selm[tid] = SEL[((size_t)(t0 + (tid >> 3)) * 2 + grp) * 8 + (tid & 7)];
        __syncthreads();
        if (tid < 8) { unsigned x = 0; for (int i = 0; i < 64; ++i) x |= selm[i * 8 + tid]; uni[tid] = x; }
        __syncthreads();
        if (tid < 256) {
            const int wq = tid >> 5; unsigned below = 0, total = 0;
#pragma unroll
            for (int w = 0; w < 8; ++w) { const unsigned x = uni[w]; const unsigned pc = __builtin_popcount(x); total += pc; below += (w < wq) ? pc : 0u; }
            const unsigned mine = uni[wq];
            if ((mine >> (tid & 31)) & 1u) blist[below + __builtin_popcount(mine & ((1u << (tid & 31)) - 1u))] = tid;
            if (tid == 0) blist[256] = total;
        }
        __syncthreads();
        const int nblk = __builtin_amdgcn_readfirstlane((int)blist[256]);
        const int tw = t0 + 8 * wave;
        bf16x8 qf[2][2]; float mr[2], l[2]; f32x4 o[2][4]; unsigned mw[2][8];
#pragma unroll
        for (int qt = 0; qt < 2; ++qt) {
            const int tok = tw + 4 * qt + (r >> 2), head = r & 3;
            const bf16_t* qp = Q + (size_t)tok * 512 + (grp * 4 + head) * 64 + 8 * g; const bf16_t* kp = Kg + (size_t)tok * 128 + grp * 64 + 8 * g;
            qf[qt][0] = *(const bf16x8*)qp; qf[qt][1] = *(const bf16x8*)(qp + 32);
            float d = 0.f;
#pragma unroll
            for (int hf = 0; hf < 2; ++hf) { const u32x4 a = __builtin_bit_cast(u32x4, qf[qt][hf]); const u32x4 b = *(const u32x4*)(kp + 32 * hf);
                d += bflo(a.x) * bflo(b.x) + bfhi(a.x) * bfhi(b.x) + bflo(a.y) * bflo(b.y) + bfhi(a.y) * bfhi(b.y) + bflo(a.z) * bflo(b.z) + bfhi(a.z) * bfhi(b.z) + bflo(a.w) * bflo(b.w) + bfhi(a.w) * bfhi(b.w); }
            mr[qt] = rsum4(d) * QK_SC; l[qt] = 0.f;
#pragma unroll
            for (int c = 0; c < 4; ++c) o[qt][c] = (f32x4){0.f, 0.f, 0.f, 0.f};
#pragma unroll
            for (int w = 0; w < 8; ++w) mw[qt][w] = selm[(8 * wave + 4 * qt + (r >> 2)) * 8 + w];
        }
        const int srow = tid >> 3, spc = tid & 7;
        const int nrounds = (nblk + 3) >> 2;
        u32x4 kreg[4], vreg[4];
#pragma unroll
        for (int b = 0; b < 4; ++b) { kreg[b] = (u32x4){0, 0, 0, 0}; vreg[b] = (u32x4){0, 0, 0, 0};
            if (b < nblk) { const int jj = __builtin_amdgcn_readfirstlane((int)blist[b]); const size_t off = (size_t)(64 * jj + srow) * 128 + grp * 64 + spc * 8; kreg[b] = *(const u32x4*)(Kg + off); vreg[b] = *(const u32x4*)(Vg + off); } }
        for (int rd = 0; rd < nrounds; ++rd) {
            __syncthreads();
#pragma unroll
            for (int b = 0; b < 4; ++b) { LAS unsigned char* kb = lds + b * KVB; *(LAS u32x4*)(kb + srow * RP + spc * 16) = kreg[b]; *(LAS u32x4*)(kb + 64 * RP + srow * RP + spc * 16) = vreg[b]; }
            __syncthreads();
#pragma unroll
            for (int b = 0; b < 4; ++b) { const int jb = (rd + 1) * 4 + b;
                if (jb < nblk) { const int jj = __builtin_amdgcn_readfirstlane((int)blist[jb]); const size_t off = (size_t)(64 * jj + srow) * 128 + grp * 64 + spc * 8; kreg[b] = *(const u32x4*)(Kg + off); vreg[b] = *(const u32x4*)(Vg + off); } }
            for (int b = 0; b < 4; ++b) {
                const int jb = rd * 4 + b; if (jb >= nblk) break;
                const int j = __builtin_amdgcn_readfirstlane((int)blist[jb]);
                LAS unsigned char* Kl = lds + b * KVB; LAS unsigned char* Vl = Kl + 64 * RP;
                bool bit[2]; bool need[2];
#pragma unroll
                for (int qt = 0; qt < 2; ++qt) {
                    unsigned wsel = mw[qt][0];
#pragma unroll
                    for (int w = 1; w < 8; ++w) wsel = ((j >> 5) == w) ? mw[qt][w] : wsel;
                    bit[qt] = (wsel >> (j & 31)) & 1u; need[qt] = __ballot(bit[qt]) != 0ull;
                }
                if (need[0] || need[1]) {
                    const bool diag = (j == cur);
#pragma unroll
                    for (int st = 0; st < 2; ++st) {
                        const KFrag kf = load_kfrag(Kl + st * 32 * RP, lane);
                        bf16x8 vf[4]; load_vfrag(vf, Vl + st * 32 * RP, lane);
#pragma unroll
                        for (int qt = 0; qt < 2; ++qt) {
                            if (!need[qt]) continue;
                            const int t = tw + 4 * qt + (r >> 2);
                            float s[8], p[8]; scores8(s, kf, qf[qt]);
#pragma unroll
                            for (int e = 0; e < 8; ++e) { const int key = 64 * j + 32 * st + 8 * g + e; const bool ok = bit[qt] && (!diag || key <= t); p[e] = ok ? fexp2(s[e] * QK_SC - mr[qt]) : 0.f; l[qt] += p[e]; }
                            const bf16x8 pf = pack8(p);
#pragma unroll
                            for (int c = 0; c < 4; ++c) o[qt][c] = mfma16(vf[c], pf, o[qt][c]);
                        }
                    }
                }
            }
        }
#pragma unroll
        for (int qt = 0; qt < 2; ++qt) {
            const int tok = tw + 4 * qt + (r >> 2), head = r & 3, hh = grp * 4 + head;
            const float sc = GA[(size_t)tok * 24 + hh * 3 + 1] / fmaxf(rsum4(l[qt]), 1e-30f);
#pragma unroll
            for (int c = 0; c < 4; ++c) { const size_t off = (size_t)tok * 512 + hh * 64 + 16 * c + 4 * g; const f32x4 b = *(const f32x4*)(OA32 + off); const f32x4 v = b + o[qt][c] * sc;
                u32x2 w; w.x = pk2(v[0], v[1]); w.y = pk2(v[2], v[3]); *(u32x2*)(OA + off) = w; }
        }
    }
}

__device__ __forceinline__ ArgsP opqa() { ArgsP p = (ArgsP)__builtin_amdgcn_kernarg_segment_ptr(); asm volatile("" : "+s"(p)); return p; }
#ifndef MIX_MASK
#define MIX_MASK 0xff
#endif
__global__ void __launch_bounds__(NTHR, 2) fwd_kernel(Args a) {
    extern __shared__ __attribute__((aligned(16))) unsigned char lds_raw[];
    LAS unsigned char* lds = (LAS unsigned char*)lds_raw;
    cg::grid_group grid = cg::this_grid();
    const int tid0 = threadIdx.x, bid0 = blockIdx.x, G0 = gridDim.x;
    #define WSP ArgsP ap = opqa(); int tid = tid0, bid = bid0, G = G0; asm volatile("" : "+v"(tid), "+s"(bid), "+s"(G)); unsigned char* ws = ap->ws; bf16_t* XB = (bf16_t*)(ws + WS_XB); float* V32 = (float*)(ws + WS_V32); bf16_t* H = (bf16_t*)(ws + WS_H); (void)XB; (void)V32; (void)H;
#pragma unroll 1
    for (int l0 = 0; l0 < DEPTH; ++l0) {
        int l = l0; asm volatile("" : "+s"(l));
        { WSP prologue_phase(ap, l, lds, tid, bid, G); }
        grid.sync();
        { WSP pg8::Gemm g{XB, (const bf16_t*)(ws + W_GU1), S, 5632, 1024}; pg8::StaticOrder so; so.init(S, 5632, G, bid); EpiFfn e{H};
          pg8::gemm_phase<EpiFfn, pg8::StaticOrder, true, true>(lds, g, so, e); }
        grid.sync();
        { WSP pg8::Gemm g{H, (const bf16_t*)(ws + W_D1), S, 1024, FF}; pg8::StaticOrder so; so.init(S, 1024, G, bid); EpiRes e{l == 0 ? ap->in[0] : ap->out, V32, 0.5f};
          pg8::gemm_phase<EpiRes, pg8::StaticOrder, true, true>(lds, g, so, e); }
        grid.sync();
        { WSP ln_phase(V32, ap->in[1] + (size_t)l * 3 * D, ap->in[2] + (size_t)l * 3 * D, ap->out, XB, tid, bid, G); }
        grid.sync();
        { WSP pg8::Gemm g{XB, (const bf16_t*)(ws + W_IN), S, NZ, 1024}; pg8::StaticOrder so; so.init(S, NZ, G, bid); EpiZ e{ws};
          pg8::gemm_phase<EpiZ, pg8::StaticOrder, true, true>(lds, g, so, e); }
        grid.sync();
        { WSP cmp_mlp_phase(ws, lds, tid, bid, G); }
        { WSP sgu_phase(ap, ws, l, lds, tid, bid, G); }
        { WSP dil_phase(ws, lds, tid, bid, G); }
        { WSP win_phase(ws, lds, tid, bid, G); }
        grid.sync();
        { WSP dil_combine(ws, tid, bid, G); }
        { WSP cmp_attn_phase(ws, lds, tid, bid, G); }
        grid.sync();
        { WSP slc_phase(ws, lds, tid, bid, G); }
        grid.sync();
        { WSP pg8::Gemm g{(const bf16_t*)(ws + WS_OA), (const bf16_t*)(ws + W_A), S, 1024, 512}; pg8::StaticOrder so; so.init(S, 1024, G, bid); EpiGate e{(const bf16_t*)(ws + WS_GM), (float*)(ws + WS_M32), (bf16_t*)(ws + WS_MB), 0, 0};
          pg8::gemm_phase<EpiGate, pg8::StaticOrder, true, true>(lds, g, so, e); }
        { WSP pg8::Gemm g{(const bf16_t*)(ws + WS_OB), (const bf16_t*)(ws + W_B), S, 1024, 256}; pg8::StaticOrder so; so.init(S, 1024, G, bid); EpiGate e{(const bf16_t*)(ws + WS_GM), (float*)(ws + WS_M32), (bf16_t*)(ws + WS_MB), 1024, 1};
          pg8::gemm_phase<EpiGate, pg8::StaticOrder, true, true>(lds, g, so, e); }
        { WSP pg8::Gemm g{(const bf16_t*)(ws + WS_OC), (const bf16_t*)(ws + W_C), S, 1024, 512}; pg8::StaticOrder so; so.init(S, 1024, G, bid); EpiGate e{(const bf16_t*)(ws + WS_GM), (float*)(ws + WS_M32), (bf16_t*)(ws + WS_MB), 2048, 2};
          pg8::gemm_phase<EpiGate, pg8::StaticOrder, true, true>(lds, g, so, e); }
        grid.sync();
        { WSP pg8::Gemm g{(const bf16_t*)(ws + WS_MB), (const bf16_t*)(ws + W_O), S, 1024, 1024}; pg8::StaticOrder so; so.init(S, 1024, G, bid); EpiRes e{ap->out, V32, 1.0f};
          pg8::gemm_phase<EpiRes, pg8::StaticOrder, true, true>(lds, g, so, e); }
        grid.sync();
        { WSP ln_phase(V32, ap->in[1] + (size_t)l * 3 * D + D, ap->in[2] + (size_t)l * 3 * D + D, ap->out, XB, tid, bid, G); }
        grid.sync();
        { WSP pg8::Gemm g{XB, (const bf16_t*)(ws + W_GU2), S, 5632, 1024}; pg8::StaticOrder so; so.init(S, 5632, G, bid); EpiFfn e{H};
          pg8::gemm_phase<EpiFfn, pg8::StaticOrder, true, true>(lds, g, so, e); }
        grid.sync();
        { WSP pg8::Gemm g{H, (const bf16_t*)(ws + W_D2), S, 1024, FF}; pg8::StaticOrder so; so.init(S, 1024, G, bid); EpiRes e{ap->out, V32, 0.5f};
          pg8::gemm_phase<EpiRes, pg8::StaticOrder, true, true>(lds, g, so, e); }
        grid.sync();
        { WSP ln_phase(V32, ap->in[1] + (size_t)l * 3 * D + 2 * D, ap->in[2] + (size_t)l * 3 * D + 2 * D, ap->out, XB, tid, bid, G); }
        grid.sync();
    }
    #undef WSP
}

extern "C" void kernel_launch(void* const* d_in, const int* in_sizes, int n_in, void* d_out, int out_size, void* d_ws, size_t ws_size, hipStream_t stream) {
    static int grid = 0;
    if (grid == 0) {
        if (n_in != 24 || in_sizes[0] != S * D || out_size != S * D || ws_size < WS_END) { fprintf(stderr, "kernel_launch: unexpected shapes (n_in %d, in0 %d, out %d, ws %zu)\n", n_in, n_in > 0 ? in_sizes[0] : -1, out_size, ws_size); grid = -1; return; }
        int dev = 0, cus = 0, per_cu = 0;
        hipGetDevice(&dev); hipDeviceGetAttribute(&cus, hipDeviceAttributeMultiprocessorCount, dev);
        if (hipFuncSetAttribute((const void*)fwd_kernel, hipFuncAttributeMaxDynamicSharedMemorySize, LDS_BYTES) != hipSuccess) { fprintf(stderr, "kernel_launch: hipFuncSetAttribute failed\n"); grid = -1; return; }
        if (hipOccupancyMaxActiveBlocksPerMultiprocessor(&per_cu, (const void*)fwd_kernel, NTHR, LDS_BYTES) != hipSuccess || per_cu < 1) { fprintf(stderr, "kernel_launch: occupancy query gave %d\n", per_cu); per_cu = 1; }
        (void)hipGetLastError();
        grid = cus;
    }
    if (grid < 0) return;
    Args a{};
    for (int i = 0; i < 24; ++i) a.in[i] = (const float*)d_in[i];
    a.out = (float*)d_out; a.ws = (unsigned char*)d_ws;
    for (int d = 0; d < 32; ++d) { const float p = (float)pow(10000.0, (double)d / 32.0); a.inv[d] = 1.0f / p; }
    void* args[] = {&a};
    hipError_t e = hipLaunchCooperativeKernel((const void*)fwd_kernel, dim3(grid), dim3(NTHR), args, LDS_BYTES, stream);
    if (e != hipSuccess) fprintf(stderr, "cooperative launch failed: %s (grid %d)\n", hipGetErrorString(e), grid);
}
```

```cpp
#include <hip/hip_runtime.h>
#include <hip/hip_cooperative_groups.h>
#include <cstdio>
#include <cstdint>
#include <cmath>
namespace cg = cooperative_groups;
namespace pg8 {
#define PG8_LAS __attribute__((address_space(3)))
typedef unsigned short bf16_t;
typedef short bf16x8 __attribute__((ext_vector_type(8)));
typedef float f32x4 __attribute__((ext_vector_type(4)));
typedef unsigned u32x4 __attribute__((ext_vector_type(4)));
constexpr int BM = 256, BK = 64, HALF = 128, HTB = HALF * BK * 2  , STAGE_BYTES = 8 * HTB, NXCD = 8, WGM = 8;

__host__ __device__ __forceinline__ int lds_byte(int r, int c) { const int st = (r >> 4) * 2 + (c >> 5), rr = r & 15, cc = c & 31, ob = rr * 64 + cc * 2; return st * 1024 + (ob ^ (((ob >> 9) & 1) << 5)); }
__host__ __device__ __forceinline__ void stage_rc(int b, int& R, int& C) { const int st = b / 1024, sb = b % 1024, swz = sb ^ (((sb >> 9) & 1) << 5); R = (st >> 1) * 16 + swz / 64; C = (st & 1) * 32 + (swz % 64) / 2; }
__host__ __device__ __forceinline__ int perm32(int rho) { const int n = rho >> 4, i = rho & 15; return 8 * (i >> 2) + 4 * n + (i & 3); }

struct Unit { int pm, pn; };
struct Gemm { const bf16_t* A; const bf16_t* Bt; int M, N, K; };

struct StaticOrder {
    int nM, nN, nwg, G, c;
    __host__ __device__ void init(int M, int N, int G_, int c_) { nM = M / BM; nN = N / BM; nwg = nM * nN; G = G_; c = c_; }
    __host__ __device__ bool next(int i, Unit& u) const {
        const long L = (long)i * G + c; if (L >= nwg) return false;
        int wgid = (int)L; { const int q = nwg / NXCD, r = nwg % NXCD, xcd = wgid % NXCD, off = wgid / NXCD; wgid = (xcd < r ? xcd * (q + 1) : r * (q + 1) + (xcd - r) * q) + off; }
        const int nig = WGM * nN, gid = wgid / nig, fm = gid * WGM, gsz = (nM - fm) < WGM ? (nM - fm) : WGM;
        u.pm = fm + ((wgid % nig) % gsz); u.pn = (wgid % nig) / gsz; return true;
    }
    __device__ __forceinline__ void a_ready(const Unit&) const {}
    __device__ __forceinline__ void done(const Unit&) const {}
};

__device__ __forceinline__ unsigned cvt_pk_bf16(float lo, float hi) { unsigned r; asm volatile("v_cvt_pk_bf16_f32 %0, %1, %2" : "=v"(r) : "v"(lo), "v"(hi)); return r; }
typedef float f32x2 __attribute__((ext_vector_type(2)));
__device__ __forceinline__ f32x2 gelu_pk(f32x2 v) {
    const f32x2 av = __builtin_elementwise_abs(v), d = av * 0.2316418882f + 1.0f;
    f32x2 t; t.x = __builtin_amdgcn_rcpf(d.x); t.y = __builtin_amdgcn_rcpf(d.y);
    f32x2 q = t * 0.5307027145f + (-0.7265760135f); q = q * t + 0.7107068705f; q = q * t + (-0.142248368f); q = q * t + 0.127414796f; q = q * t;
    const f32x2 s = (v * v) * (-0.72134752044f);
    f32x2 e; e.x = __builtin_amdgcn_exp2f(s.x); e.y = __builtin_amdgcn_exp2f(s.y);
    const f32x2 m = v * (q * e), r = v - m;
    f32x2 o; o.x = v.x < 0.f ? m.x : r.x; o.y = v.y < 0.f ? m.y : r.y; return o;
}

template <int ACT  > struct EpiBf16 {
    static constexpr bool PERM = true, AFTER_DRAIN = false; static_assert(ACT == 0 || ACT == 1, "EpiBf16: ACT is 0 (none) or 1 (gelu_pk)");
    bf16_t* O; int ldc; const float* bias; int split_cols; size_t split_stride; float scale0;
    __device__ __forceinline__ void operator()(const f32x4 (&acc)[2][2][4][2], const Unit& u, int wr, int wc, int fr, int fq) const {
        const int row0 = u.pm * BM + wr * 64 + fr; int colt = u.pn * BM; bf16_t* base = O;
        float sc = 1.f; if (split_cols) { const int t = colt / split_cols; base += (size_t)t * split_stride; colt -= t * split_cols; if (t == 0) sc = scale0; }
        const int col0 = colt + wc * 32 + 8 * fq, bcol0 = u.pn * BM + wc * 32 + 8 * fq;
        f32x4 bv[2][2];
#pragma unroll
        for (int bj = 0; bj < 2; ++bj)
#pragma unroll
            for (int n = 0; n < 2; ++n) bv[bj][n] = bias ? *(const f32x4*)(bias + bcol0 + bj * HALF + 4 * n) : (f32x4){0.f, 0.f, 0.f, 0.f};
#pragma unroll
        for (int ai = 0; ai < 2; ++ai)
#pragma unroll
            for (int m = 0; m < 4; ++m) { bf16_t* rowp = base + (size_t)(row0 + ai * HALF + m * 16) * ldc + col0;
#pragma unroll
                for (int bj = 0; bj < 2; ++bj) { f32x4 v0 = acc[ai][bj][m][0] + bv[bj][0], v1 = acc[ai][bj][m][1] + bv[bj][1];
                    if (ACT == 1) { f32x2 a = gelu_pk((f32x2){v0[0], v0[1]}), b = gelu_pk((f32x2){v0[2], v0[3]}), c = gelu_pk((f32x2){v1[0], v1[1]}), d = gelu_pk((f32x2){v1[2], v1[3]});
                        v0 = (f32x4){a.x, a.y, b.x, b.y}; v1 = (f32x4){c.x, c.y, d.x, d.y}; }
                    v0 = v0 * sc; v1 = v1 * sc; u32x4 w; w.x = cvt_pk_bf16(v0[0], v0[1]); w.y = cvt_pk_bf16(v0[2], v0[3]); w.z = cvt_pk_bf16(v1[0], v1[1]); w.w = cvt_pk_bf16(v1[2], v1[3]);
                    *(u32x4*)(rowp + bj * HALF) = w; } }
    }
};


template <class Epi, class Sched, bool ALIGN_EPI = false, bool SP2 = false>
__device__ __forceinline__ void gemm_phase(PG8_LAS unsigned char* lds, const Gemm g, const Sched& S, const Epi& E) {
    int tid_ = threadIdx.x; asm volatile("" : "+v"(tid_)); const int tid = tid_, wid = __builtin_amdgcn_readfirstlane(tid >> 6), lane = tid & 63, wr = wid >> 2, wc = wid & 3, fr = lane & 15, fq = lane >> 4;
    const int K = g.K, nt = K / BK;
    unsigned voffA[2], voffB[2];
#pragma unroll
    for (int i = 0; i < 2; ++i) { int R, C; stage_rc(tid * 16 + i * 8192, R, C); const int Rb = Epi::PERM ? ((R & ~31) + perm32(R & 31)) : R;
        voffA[i] = (unsigned)(R * K + C) * 2u; voffB[i] = (unsigned)(Rb * K + C) * 2u; }
    const size_t kstep = (size_t)(BK * 2);
    const size_t hstep = (size_t)HALF * K * 2;
    const size_t tstep = 2 * hstep;
    const unsigned ldsw = (unsigned)wid * 1024u;
    const int aoff = lds_byte(wr * 64 + fr, fq * 8), boff = lds_byte(wc * 32 + fr, fq * 8);
#define PG8_SA(b, h) (((b) * 2 + (h)) * HTB)
#define PG8_SB(b, h) ((4 + (b) * 2 + (h)) * HTB)
#define PG8_STAGE(bufoff, gbase, voff) do { _Pragma("unroll") for (int _i = 0; _i < 2; ++_i) \
        __builtin_amdgcn_global_load_lds((const unsigned*)((const char*)(gbase) + (voff)[_i]), (PG8_LAS unsigned*)(lds + (bufoff) + ldsw + _i * 8192), 16, 0, 0); } while (0)
#define PG8_LDA(dst, b, h) do { _Pragma("unroll") for (int m = 0; m < 4; ++m) _Pragma("unroll") for (int k = 0; k < 2; ++k) dst[m][k] = *(const PG8_LAS bf16x8*)(lds + PG8_SA(b, h) + aoff + m * 2048 + k * 1024); } while (0)
#define PG8_LDB(dst, b, h) do { _Pragma("unroll") for (int n = 0; n < 2; ++n) _Pragma("unroll") for (int k = 0; k < 2; ++k) dst[n][k] = *(const PG8_LAS bf16x8*)(lds + PG8_SB(b, h) + boff + n * 2048 + k * 1024); } while (0)
#define PG8_MMA(ai, bj, At, Bt) do { __builtin_amdgcn_s_setprio(1); _Pragma("unroll") for (int m = 0; m < 4; ++m) _Pragma("unroll") for (int n = 0; n < 2; ++n) _Pragma("unroll") for (int k = 0; k < 2; ++k) \
        acc[ai][bj][m][n] = __builtin_amdgcn_mfma_f32_16x16x32_bf16(Bt[n][k], At[m][k], acc[ai][bj][m][n], 0, 0, 0); __builtin_amdgcn_s_setprio(0); } while (0)
#define PG8_WAIT_V(n) asm volatile("s_waitcnt vmcnt(" #n ")" ::: "memory")
#define PG8_WAIT_L(n) asm volatile("s_waitcnt lgkmcnt(" #n ")" ::: "memory")
#define PG8_BAR __builtin_amdgcn_s_barrier()
#define PG8_SCHED __builtin_amdgcn_sched_barrier(0)
    Unit cur, nxt; int ui = 0;
    if (!S.next(0, cur)) return;
    f32x4 acc[2][2][4][2];
#pragma unroll
    for (int a = 0; a < 2; ++a)
#pragma unroll
        for (int b = 0; b < 2; ++b)
#pragma unroll
            for (int m = 0; m < 4; ++m)
#pragma unroll
                for (int n = 0; n < 2; ++n) acc[a][b][m][n] = (f32x4){0.f, 0.f, 0.f, 0.f};
    bf16x8 At[4][2], B0[2][2], B1[2][2];
    const char* cA = (const char*)g.A + (size_t)cur.pm * tstep; const char* cB = (const char*)g.Bt + (size_t)cur.pn * tstep;
    S.a_ready(cur);
    if constexpr (SP2) {
        PG8_STAGE(PG8_SB(0, 0), cB, voffB); PG8_STAGE(PG8_SB(0, 1), cB + hstep, voffB); PG8_STAGE(PG8_SA(0, 0), cA, voffA); PG8_STAGE(PG8_SA(0, 1), cA + hstep, voffA);
        if (wr == 1) PG8_BAR;
        PG8_WAIT_V(2); PG8_BAR;
        PG8_STAGE(PG8_SB(1, 0), cB + kstep, voffB); PG8_STAGE(PG8_SA(1, 0), cA + kstep, voffA); PG8_STAGE(PG8_SB(1, 1), cB + hstep + kstep, voffB);
        PG8_WAIT_V(6); PG8_BAR;
    } else {
        PG8_STAGE(PG8_SB(0, 0), cB, voffB); PG8_STAGE(PG8_SA(0, 0), cA, voffA); PG8_STAGE(PG8_SB(0, 1), cB + hstep, voffB); PG8_STAGE(PG8_SA(0, 1), cA + hstep, voffA);
        if (wr == 1) PG8_BAR;
        PG8_WAIT_V(4); PG8_BAR;
        PG8_STAGE(PG8_SB(1, 0), cB + kstep, voffB); PG8_STAGE(PG8_SA(1, 0), cA + kstep, voffA); PG8_STAGE(PG8_SB(1, 1), cB + hstep + kstep, voffB);
        PG8_WAIT_V(6); PG8_BAR;
    }
    for (;;) {
        const bool has_next = S.next(ui + 1, nxt);
        const char* nA = has_next ? (const char*)g.A + (size_t)nxt.pm * tstep : cA; const char* nB = has_next ? (const char*)g.Bt + (size_t)nxt.pn * tstep : cB;
        for (int t = 0; t < nt; t += 2) {
            const bool last = (t == nt - 2);
            const char* a1 = cA + (size_t)(t + 1) * kstep;
            const char* a2 = last ? nA : cA + (size_t)(t + 2) * kstep; const char* b2 = last ? nB : cB + (size_t)(t + 2) * kstep;
            const char* a3 = a2 + kstep; const char* b3 = b2 + kstep;
            if (last && has_next) S.a_ready(nxt);
            if constexpr (SP2) {
            PG8_LDB(B0, 0, 0); PG8_LDB(B1, 0, 1); PG8_SCHED; PG8_LDA(At, 0, 0); PG8_STAGE(PG8_SA(1, 1), a1 + hstep, voffA);
            PG8_WAIT_V(8); PG8_WAIT_L(0); PG8_BAR; PG8_MMA(0, 0, At, B0); PG8_MMA(0, 1, At, B1); PG8_BAR; PG8_SCHED;
            PG8_LDA(At, 0, 1); PG8_STAGE(PG8_SB(0, 0), b2, voffB); PG8_STAGE(PG8_SB(0, 1), b2 + hstep, voffB); PG8_STAGE(PG8_SA(0, 0), a2, voffA);
            PG8_WAIT_V(8); PG8_WAIT_L(0); PG8_BAR; PG8_MMA(1, 0, At, B0); PG8_MMA(1, 1, At, B1); PG8_BAR; PG8_SCHED;
            PG8_LDB(B0, 1, 0); PG8_LDB(B1, 1, 1); PG8_SCHED; PG8_LDA(At, 1, 0); PG8_STAGE(PG8_SA(0, 1), a2 + hstep, voffA);
            PG8_WAIT_V(8); PG8_WAIT_L(0); PG8_BAR; PG8_MMA(0, 0, At, B0); PG8_MMA(0, 1, At, B1); PG8_BAR; PG8_SCHED;
            PG8_LDA(At, 1, 1); PG8_STAGE(PG8_SB(1, 0), b3, voffB); PG8_STAGE(PG8_SB(1, 1), b3 + hstep, voffB); PG8_STAGE(PG8_SA(1, 0), a3, voffA);
            PG8_WAIT_V(8); PG8_WAIT_L(0); PG8_BAR; PG8_MMA(1, 0, At, B0); PG8_MMA(1, 1, At, B1); PG8_BAR; PG8_SCHED;
            } else {
            PG8_LDB(B0, 0, 0); PG8_SCHED; PG8_LDA(At, 0, 0); PG8_STAGE(PG8_SA(1, 1), a1 + hstep, voffA);
            PG8_WAIT_L(8); PG8_BAR; PG8_WAIT_L(0); PG8_MMA(0, 0, At, B0); PG8_BAR; PG8_SCHED;
            PG8_LDB(B1, 0, 1); PG8_STAGE(PG8_SB(0, 0), b2, voffB);
            PG8_BAR; PG8_WAIT_L(0); PG8_MMA(0, 1, At, B1); PG8_BAR;
            PG8_LDA(At, 0, 1); PG8_STAGE(PG8_SA(0, 0), a2, voffA);
            PG8_BAR; PG8_WAIT_L(0); PG8_MMA(1, 0, At, B0); PG8_BAR; PG8_SCHED;
            PG8_STAGE(PG8_SB(0, 1), b2 + hstep, voffB);
            PG8_WAIT_V(6); PG8_BAR; PG8_MMA(1, 1, At, B1); PG8_BAR;
            PG8_LDB(B0, 1, 0); PG8_SCHED; PG8_LDA(At, 1, 0); PG8_STAGE(PG8_SA(0, 1), a2 + hstep, voffA);
            PG8_WAIT_L(8); PG8_BAR; PG8_WAIT_L(0); PG8_MMA(0, 0, At, B0); PG8_BAR; PG8_SCHED;
            PG8_LDB(B1, 1, 1); PG8_STAGE(PG8_SB(1, 0), b3, voffB);
            PG8_BAR; PG8_WAIT_L(0); PG8_MMA(0, 1, At, B1); PG8_BAR;
            PG8_LDA(At, 1, 1); PG8_STAGE(PG8_SA(1, 0), a3, voffA);
            PG8_BAR; PG8_WAIT_L(0); PG8_MMA(1, 0, At, B0); PG8_BAR; PG8_SCHED;
            PG8_STAGE(PG8_SB(1, 1), b3 + hstep, voffB);
            PG8_WAIT_V(6); PG8_BAR; PG8_MMA(1, 1, At, B1); PG8_BAR;
            }
        }
        if constexpr (ALIGN_EPI) { if (wr == 0) PG8_BAR; }
        if constexpr (!Epi::AFTER_DRAIN) { E(acc, cur, wr, wc, fr, fq); S.done(cur); }
        if (!has_next) break;
#pragma unroll
        for (int a = 0; a < 2; ++a)
#pragma unroll
            for (int b = 0; b < 2; ++b)
#pragma unroll
                for (int m = 0; m < 4; ++m)
#pragma unroll
                    for (int n = 0; n < 2; ++n) acc[a][b][m][n] = (f32x4){0.f, 0.f, 0.f, 0.f};
        cur = nxt; cA = nA; cB = nB; ++ui;
        if constexpr (ALIGN_EPI) { if (wr == 1) PG8_BAR; }
    }
    PG8_WAIT_V(0);
    if constexpr (!ALIGN_EPI) { if (wr == 0) PG8_BAR; }
    PG8_BAR;
    if constexpr (Epi::AFTER_DRAIN) { E.fused(acc, cur, wr, wc, fr, fq, lds, wid, lane); S.done(cur); }
#undef PG8_SA
#undef PG8_SB
#undef PG8_STAGE
#undef PG8_LDA
#undef PG8_LDB
#undef PG8_MMA
#undef PG8_WAIT_V
#undef PG8_WAIT_L
#undef PG8_BAR
#undef PG8_SCHED
}
}

#define LAS __attribute__((address_space(3)))
typedef unsigned short bf16_t;
typedef short bf16x8 __attribute__((ext_vector_type(8)));
typedef short s16x4 __attribute__((ext_vector_type(4)));
typedef short v4i16_t __attribute__((ext_vector_type(4)));
typedef float f32x4 __attribute__((ext_vector_type(4)));
typedef unsigned u32x4 __attribute__((ext_vector_type(4)));
typedef unsigned u32x2 __attribute__((ext_vector_type(2)));

constexpr int S = 16384, D = 1024, FF = 2816, DEPTH = 4, NZ = 7936, INC = 7704;
constexpr float ALPHA = 1.6817928305074292f;
constexpr float LN_EPS = 1e-5f;
constexpr float LOG2E = 1.4426950408889634f;
constexpr float QK_SC = 0.125f * LOG2E;
constexpr int NTHR = 512;
constexpr int LDS_BYTES = 155648;

constexpr size_t MiB = 1u << 20;
constexpr size_t W_GU1 = 1 * MiB;
constexpr size_t W_D1 = W_GU1 + (size_t)5632 * 1024 * 2;
constexpr size_t W_GU2 = W_D1 + (size_t)1024 * 2816 * 2;
constexpr size_t W_D2 = W_GU2 + (size_t)5632 * 1024 * 2;
constexpr size_t W_IN = W_D2 + (size_t)1024 * 2816 * 2;
constexpr size_t W_A = W_IN + (size_t)NZ * 1024 * 2;
constexpr size_t W_B = W_A + (size_t)1024 * 512 * 2;
constexpr size_t W_C = W_B + (size_t)1024 * 256 * 2;
constexpr size_t W_O = W_C + (size_t)1024 * 512 * 2;
constexpr size_t W_P1K = W_O + (size_t)1024 * 1024 * 2;
constexpr size_t W_P1V = W_P1K + (size_t)128 * 2048 * 2;
constexpr size_t W_P2K = W_P1V + (size_t)128 * 2048 * 2;
constexpr size_t W_P2V = W_P2K + (size_t)64 * 128 * 2;
constexpr size_t W_SGU = W_P2V + (size_t)64 * 128 * 2;
constexpr size_t W_PB = W_SGU + (size_t)4 * 128 * 128 * 2;
constexpr size_t W_END = W_PB + 2 * 128 * 4;
static_assert(W_END <= 57 * MiB, "weights region");
constexpr size_t WS_COS = 57 * MiB, WS_SIN = 59 * MiB;
constexpr size_t WS_XB = 61 * MiB;
constexpr size_t WS_V32 = 93 * MiB, WS_OA32 = WS_V32, WS_OA32B = WS_V32 + 32 * MiB;
constexpr size_t WS_H = 157 * MiB;
constexpr size_t WS_QAR = 157 * MiB, WS_QAT = 173 * MiB, WS_KS = 189 * MiB, WS_KW = 193 * MiB, WS_KC = 197 * MiB, WS_VC = 201 * MiB, WS_VS = 205 * MiB, WS_VW = 209 * MiB;
constexpr size_t WS_QB = 213 * MiB, WS_KB = 237 * MiB, WS_VB = 261 * MiB, WS_UVG = 285 * MiB, WS_GM = 317 * MiB, WS_GA = 413 * MiB;
constexpr size_t WS_M32 = 213 * MiB, WS_MB = 285 * MiB;
constexpr size_t WS_OA = 415 * MiB, WS_OB = 431 * MiB, WS_OC = 439 * MiB, WS_OD = 455 * MiB, WS_LSE = 479 * MiB, WS_SEL = 480 * MiB, WS_KCMP = 481 * MiB, WS_VCMP = 481 * MiB + 512 * 1024;
constexpr size_t WS_END = 482 * MiB;

struct Args { const float* in[24]; float* out; unsigned char* ws; float inv[32]; };
typedef const __attribute__((address_space(4))) Args* ArgsP;

__device__ __forceinline__ unsigned f2bf(float f) { unsigned u = __builtin_bit_cast(unsigned, f); return (u + 0x7fffu + ((u >> 16) & 1u)) >> 16; }
__device__ __forceinline__ unsigned pk2(float lo, float hi) { return pg8::cvt_pk_bf16(lo, hi); }
__device__ __forceinline__ float bf2f(unsigned short b) { return __builtin_bit_cast(float, (unsigned)b << 16); }
__device__ __forceinline__ float bflo(unsigned w) { return __builtin_bit_cast(float, w << 16); }
__device__ __forceinline__ float bfhi(unsigned w) { return __builtin_bit_cast(float, w & 0xffff0000u); }
__device__ __forceinline__ float fexp2(float x) { return __builtin_amdgcn_exp2f(x); }
__device__ __forceinline__ float frcp(float x) { return __builtin_amdgcn_rcpf(x); }
__device__ __forceinline__ float sigmoidf_(float x) { return frcp(1.0f + fexp2(-x * LOG2E)); }
__device__ __forceinline__ float siluf_(float x) { return x * sigmoidf_(x); }
__device__ __forceinline__ float gelu_tanh(float x) { const float u = 0.7978845608028654f * (x + 0.044715f * x * x * x); return x * frcp(1.0f + fexp2(-2.0f * LOG2E * u)); }
__device__ __forceinline__ float wave_sum(float v) {
#pragma unroll
    for (int o = 1; o < 64; o <<= 1) v += __shfl_xor(v, o);
    return v;
}
__device__ __forceinline__ f32x4 mfma16(bf16x8 a, bf16x8 b, f32x4 c) { return __builtin_amdgcn_mfma_f32_16x16x32_bf16(a, b, c, 0, 0, 0); }
__device__ __forceinline__ s16x4 tr_read(LAS const unsigned char* p) { return __builtin_bit_cast(s16x4, __builtin_amdgcn_ds_read_tr16_b64_v4i16((LAS v4i16_t*)p)); }
__device__ __forceinline__ bf16x8 cat8(s16x4 lo, s16x4 hi) { return (bf16x8){lo[0], lo[1], lo[2], lo[3], hi[0], hi[1], hi[2], hi[3]}; }
__device__ __forceinline__ bf16x8 pack8(const float (&p)[8]) {
    u32x4 w; w.x = pk2(p[0], p[1]); w.y = pk2(p[2], p[3]); w.z = pk2(p[4], p[5]); w.w = pk2(p[6], p[7]);
    return __builtin_bit_cast(bf16x8, w);
}

struct EpiFfn {
    static constexpr bool PERM = true, AFTER_DRAIN = false;
    bf16_t* H;
    __device__ __forceinline__ void operator()(const f32x4 (&acc)[2][2][4][2], const pg8::Unit& u, int wr, int wc, int fr, int fq) const {
        const int row0 = u.pm * 256 + wr * 64 + fr, col0 = u.pn * 128 + wc * 32 + 8 * fq;
#pragma unroll
        for (int ai = 0; ai < 2; ++ai)
#pragma unroll
            for (int m = 0; m < 4; ++m) {
                bf16_t* rowp = H + (size_t)(row0 + ai * 128 + m * 16) * FF + col0;
                float h[8];
#pragma unroll
                for (int n = 0; n < 2; ++n)
#pragma unroll
                    for (int i = 0; i < 4; ++i) h[4 * n + i] = siluf_(acc[ai][0][m][n][i]) * acc[ai][1][m][n][i];
                u32x4 w; w.x = pk2(h[0], h[1]); w.y = pk2(h[2], h[3]); w.z = pk2(h[4], h[5]); w.w = pk2(h[6], h[7]);
                *(u32x4*)rowp = w;
            }
    }
};
struct EpiRes {
    static constexpr bool PERM = false, AFTER_DRAIN = false;
    const float* X; float* V; float sc;
    __device__ __forceinline__ void operator()(const f32x4 (&acc)[2][2][4][2], const pg8::Unit& u, int wr, int wc, int fr, int fq) const {
        const int row0 = u.pm * 256 + wr * 64 + fr, col0 = u.pn * 256 + wc * 32 + 4 * fq;
#pragma unroll
        for (int ai = 0; ai < 2; ++ai)
#pragma unroll
            for (int m = 0; m < 4; ++m) {
                const size_t off = (size_t)(row0 + ai * 128 + m * 16) * D + col0;
#pragma unroll
                for (int bj = 0; bj < 2; ++bj)
#pragma unroll
                    for (int n = 0; n < 2; ++n) {
                        const f32x4 x = *(const f32x4*)(X + off + bj * 128 + n * 16);
                        *(f32x4*)(V + off + bj * 128 + n * 16) = x * ALPHA + acc[ai][bj][m][n] * sc;
                    }
            }
    }
};
struct EpiGate {
    static constexpr bool PERM = true, AFTER_DRAIN = false;
    const bf16_t* GM; float* M32; bf16_t* MB; int goff, mode;
    __device__ __forceinline__ void operator()(const f32x4 (&acc)[2][2][4][2], const pg8::Unit& u, int wr, int wc, int fr, int fq) const {
        const int row0 = u.pm * 256 + wr * 64 + fr, col0 = u.pn * 256 + wc * 32 + 8 * fq;
#pragma unroll
        for (int ai = 0; ai < 2; ++ai)
#pragma unroll
            for (int m = 0; m < 4; ++m) {
                const int row = row0 + ai * 128 + m * 16;
#pragma unroll
                for (int bj = 0; bj < 2; ++bj) {
                    const int col = col0 + bj * 128;
                    const u32x4 gw = *(const u32x4*)(GM + (size_t)row * 3072 + goff + col);
                    float v[8];
                    v[0] = bflo(gw.x) * acc[ai][bj][m][0][0]; v[1] = bfhi(gw.x) * acc[ai][bj][m][0][1]; v[2] = bflo(gw.y) * acc[ai][bj][m][0][2]; v[3] = bfhi(gw.y) * acc[ai][bj][m][0][3];
                    v[4] = bflo(gw.z) * acc[ai][bj][m][1][0]; v[5] = bfhi(gw.z) * acc[ai][bj][m][1][1]; v[6] = bflo(gw.w) * acc[ai][bj][m][1][2]; v[7] = bfhi(gw.w) * acc[ai][bj][m][1][3];
                    float* mp = M32 + (size_t)row * D + col;
                    if (mode != 0) { const f32x4 a = *(const f32x4*)mp, b = *(const f32x4*)(mp + 4); v[0] += a[0]; v[1] += a[1]; v[2] += a[2]; v[3] += a[3]; v[4] += b[0]; v[5] += b[1]; v[6] += b[2]; v[7] += b[3]; }
                    if (mode != 2) { *(f32x4*)mp = (f32x4){v[0], v[1], v[2], v[3]}; *(f32x4*)(mp + 4) = (f32x4){v[4], v[5], v[6], v[7]}; }
                    else { u32x4 w; w.x = pk2(v[0], v[1]); w.y = pk2(v[2], v[3]); w.z = pk2(v[4], v[5]); w.w = pk2(v[6], v[7]); *(u32x4*)(MB + (size_t)row * D + col) = w; }
                }
            }
    }
};
struct EpiZ {
    static constexpr bool PERM = true, AFTER_DRAIN = false;
    unsigned char* ws;
    __device__ __forceinline__ void operator()(const f32x4 (&acc)[2][2][4][2], const pg8::Unit& u, int wr, int wc, int fr, int fq) const {
        const int pn = u.pn, row0 = u.pm * 256 + wr * 64 + fr;
        if (pn <= 8) {
            bf16_t* dst; bf16_t* raw = nullptr; int ld, hcol;
            if (pn <= 1) { dst = (bf16_t*)(ws + WS_QAT); raw = (bf16_t*)(ws + WS_QAR); ld = 512; hcol = (pn * 4 + wc) * 64; }
            else if (pn == 2) { dst = (bf16_t*)(ws + (wc < 2 ? WS_KS : WS_KW)); ld = 128; hcol = (wc & 1) * 64; }
            else if (pn <= 5) { dst = (bf16_t*)(ws + WS_QB); ld = 768; hcol = ((pn - 3) * 4 + wc) * 64; }
            else { dst = (bf16_t*)(ws + WS_KB); ld = 768; hcol = ((pn - 6) * 4 + wc) * 64; }
            const float* ct = (const float*)(ws + WS_COS); const float* st = (const float*)(ws + WS_SIN);
#pragma unroll
            for (int ai = 0; ai < 2; ++ai)
#pragma unroll
                for (int m = 0; m < 4; ++m) {
                    const int row = row0 + ai * 128 + m * 16;
                    const f32x4 c0 = *(const f32x4*)(ct + row * 32 + 8 * fq), c1 = *(const f32x4*)(ct + row * 32 + 8 * fq + 4);
                    const f32x4 s0 = *(const f32x4*)(st + row * 32 + 8 * fq), s1 = *(const f32x4*)(st + row * 32 + 8 * fq + 4);
                    const f32x4 a0 = acc[ai][0][m][0], a1 = acc[ai][0][m][1], b0 = acc[ai][1][m][0], b1 = acc[ai][1][m][1];
                    const f32x4 o10 = a0 * c0 - b0 * s0, o11 = a1 * c1 - b1 * s1, o20 = b0 * c0 + a0 * s0, o21 = b1 * c1 + a1 * s1;
                    bf16_t* p = dst + (size_t)row * ld + hcol + 8 * fq;
                    u32x4 w; w.x = pk2(o10[0], o10[1]); w.y = pk2(o10[2], o10[3]); w.z = pk2(o11[0], o11[1]); w.w = pk2(o11[2], o11[3]); *(u32x4*)p = w;
                    w.x = pk2(o20[0], o20[1]); w.y = pk2(o20[2], o20[3]); w.z = pk2(o21[0], o21[1]); w.w = pk2(o21[2], o21[3]); *(u32x4*)(p + 32) = w;
                    if (raw) { bf16_t* q = raw + (size_t)row * ld + hcol + 8 * fq;
                        w.x = pk2(a0[0], a0[1]); w.y = pk2(a0[2], a0[3]); w.z = pk2(a1[0], a1[1]); w.w = pk2(a1[2], a1[3]); *(u32x4*)q = w;
                        w.x = pk2(b0[0], b0[1]); w.y = pk2(b0[2], b0[3]); w.z = pk2(b1[0], b1[1]); w.w = pk2(b1[2], b1[3]); *(u32x4*)(q + 32) = w; }
                }
        } else if (pn <= 29) {
            const int act = pn <= 13 ? 0 : (pn <= 17 ? 1 : 2);
#pragma unroll
            for (int bj = 0; bj < 2; ++bj) {
                bf16_t* dst; int ld, c0;
                if (pn == 9) { dst = (bf16_t*)(ws + (bj ? WS_VC : WS_KC)); ld = 128; c0 = 0; }
                else if (pn == 10) { dst = (bf16_t*)(ws + (bj ? WS_VW : WS_VS)); ld = 128; c0 = 0; }
                else if (pn <= 13) { dst = (bf16_t*)(ws + WS_VB); ld = 768; c0 = (pn - 11) * 256 + bj * 128; }
                else if (pn <= 17) { dst = (bf16_t*)(ws + WS_UVG); ld = 1024; c0 = (pn - 14) * 256 + bj * 128; }
                else { dst = (bf16_t*)(ws + WS_GM); ld = 3072; c0 = (pn - 18) * 256 + bj * 128; }
                c0 += wc * 32 + 8 * fq;
#pragma unroll
                for (int ai = 0; ai < 2; ++ai)
#pragma unroll
                    for (int m = 0; m < 4; ++m) {
                        const int row = row0 + ai * 128 + m * 16;
                        float v[8];
#pragma unroll
                        for (int n = 0; n < 2; ++n)
#pragma unroll
                            for (int i = 0; i < 4; ++i) { const float x = acc[ai][bj][m][n][i]; v[4 * n + i] = act == 0 ? x : (act == 1 ? gelu_tanh(x) : sigmoidf_(x)); }
                        u32x4 w; w.x = pk2(v[0], v[1]); w.y = pk2(v[2], v[3]); w.z = pk2(v[4], v[5]); w.w = pk2(v[6], v[7]);
                        *(u32x4*)(dst + (size_t)row * ld + c0) = w;
                    }
            }
        } else {
            if (wc == 0 && fq < 3) {
                float* ga = (float*)(ws + WS_GA);
#pragma unroll
                for (int ai = 0; ai < 2; ++ai)
#pragma unroll
                    for (int m = 0; m < 4; ++m) {
                        const int row = row0 + ai * 128 + m * 16;
#pragma unroll
                        for (int n = 0; n < 2; ++n) { const f32x4 x = acc[ai][0][m][n];
                            *(f32x4*)(ga + (size_t)row * 24 + 8 * fq + 4 * n) = (f32x4){sigmoidf_(x[0]), sigmoidf_(x[1]), sigmoidf_(x[2]), sigmoidf_(x[3])}; }
                    }
            }
        }
    }
};

__device__ __forceinline__ int win_col0(int dg) {
    const int pn = dg >> 3, q = dg & 7, hs = q & 3, half = q >> 2;
    if (pn <= 1) return (pn * 4 + hs) * 64 + 32 * half;
    if (pn == 2) return (hs == 0 ? 768 : hs == 1 ? 832 : hs == 2 ? 1024 : 1088) + 32 * half;
    if (pn <= 5) return 1304 + ((pn - 3) * 4 + hs) * 64 + 32 * half;
    if (pn <= 8) return 2072 + ((pn - 6) * 4 + hs) * 64 + 32 * half;
    if (pn == 9) return (q < 4 ? 512 : 640) + 32 * (q & 3);
    if (pn == 10) return (q < 4 ? 896 : 1152) + 32 * (q & 3);
    if (pn <= 13) return 2840 + (pn - 11) * 256 + 32 * q;
    if (pn <= 17) return 3608 + (pn - 14) * 256 + 32 * q;
    if (pn <= 29) return 4632 + (pn - 18) * 256 + 32 * q;
    return q == 0 ? 1280 : -1;
}

__device__ __forceinline__ void transpose_item(const float* W, int ldw, int col0, int k0, bf16_t* dst, int K, LAS float* scr, int lane) {
    if (col0 >= 0) {
#pragma unroll 8
        for (int i = 0; i < 32; ++i) { const int kk = 2 * i + (lane >> 5); scr[kk * 33 + (lane & 31)] = W[(size_t)(k0 + kk) * ldw + col0 + (lane & 31)]; }
    } else {
#pragma unroll 8
        for (int i = 0; i < 32; ++i) { const int kk = 2 * i + (lane >> 5); scr[kk * 33 + (lane & 31)] = 0.f; }
    }
    asm volatile("s_waitcnt lgkmcnt(0)" ::: "memory");
    const int c = lane & 7;
#pragma unroll
    for (int j = 0; j < 4; ++j) { const int n = (lane >> 3) + 8 * j; const LAS float* s = scr + (8 * c) * 33 + n;
        u32x4 o; o.x = pk2(s[0 * 33], s[1 * 33]); o.y = pk2(s[2 * 33], s[3 * 33]); o.z = pk2(s[4 * 33], s[5 * 33]); o.w = pk2(s[6 * 33], s[7 * 33]);
        *(u32x4*)(dst + (size_t)n * K + 8 * c) = o; }
    asm volatile("s_waitcnt lgkmcnt(0)" ::: "memory");
}

__device__ __forceinline__ void prologue_phase(ArgsP a, int l, LAS unsigned char* lds, int tid, int bid, int G) {
    const int lane = tid & 63, wave = tid >> 6;
    LAS float* scr = (LAS float*)(lds + wave * 16384);
    unsigned char* ws = a->ws;
    const int gw = bid * 8 + wave, NGW = G * 8;
    const float* g1 = a->in[3] + (size_t)l * D * FF; const float* u1 = a->in[4] + (size_t)l * D * FF; const float* d1 = a->in[5] + (size_t)l * FF * D;
    const float* g2 = a->in[6] + (size_t)l * D * FF; const float* u2 = a->in[7] + (size_t)l * D * FF; const float* d2 = a->in[8] + (size_t)l * FF * D;
    const float* win = a->in[9] + (size_t)l * D * INC;
    const float* pkw1 = a->in[11] + (size_t)l * 2048 * 128; const float* pkw2 = a->in[12] + (size_t)l * 128 * 64;
    const float* pvw1 = a->in[14] + (size_t)l * 2048 * 128; const float* pvw2 = a->in[15] + (size_t)l * 128 * 64;
    const float* wa = a->in[20] + (size_t)l * 512 * D; const float* wb = a->in[21] + (size_t)l * 256 * D; const float* wc = a->in[22] + (size_t)l * 512 * D; const float* wo = a->in[23] + (size_t)l * D * D;
    constexpr int I_GU = 16 * 176, I_D = 44 * 32, I_IN = 16 * 248, I_A = 8 * 32, I_B = 4 * 32, I_O = 16 * 32, I_P1 = 32 * 4, I_P2 = 2 * 2;
    constexpr int NIT = 2 * I_GU + 2 * I_D + I_IN + 2 * I_A + I_B + I_O + 2 * I_P1 + 2 * I_P2;
    for (int it = gw; it < NIT; it += NGW) {
        int r = it; const float* src; int ldw, col0, kb, dg, K; size_t dbase;
        if (r < 2 * I_GU) { const int f = r >= I_GU; if (f) r -= I_GU; kb = r / 176; dg = r % 176; const int pn = dg >> 3, q = dg & 7;
            src = (q < 4) ? (f ? g2 : g1) : (f ? u2 : u1); ldw = FF; col0 = 128 * pn + 32 * (q & 3); K = 1024; dbase = f ? W_GU2 : W_GU1; }
        else if ((r -= 2 * I_GU) < 2 * I_D) { const int f = r >= I_D; if (f) r -= I_D; kb = r / 32; dg = r % 32; src = f ? d2 : d1; ldw = D; col0 = 32 * dg; K = FF; dbase = f ? W_D2 : W_D1; }
        else if ((r -= 2 * I_D) < I_IN) { kb = r / 248; dg = r % 248; src = win; ldw = INC; col0 = win_col0(dg); K = 1024; dbase = W_IN; }
        else if ((r -= I_IN) < I_A) { kb = r / 32; dg = r % 32; src = wa; ldw = D; col0 = 32 * dg; K = 512; dbase = W_A; }
        else if ((r -= I_A) < I_A) { kb = r / 32; dg = r % 32; src = wc; ldw = D; col0 = 32 * dg; K = 512; dbase = W_C; }
        else if ((r -= I_A) < I_B) { kb = r / 32; dg = r % 32; src = wb; ldw = D; col0 = 32 * dg; K = 256; dbase = W_B; }
        else if ((r -= I_B) < I_O) { kb = r / 32; dg = r % 32; src = wo; ldw = D; col0 = 32 * dg; K = 1024; dbase = W_O; }
        else if ((r -= I_O) < 2 * I_P1) { const int f = r >= I_P1; if (f) r -= I_P1; kb = r / 4; dg = r % 4; src = f ? pvw1 : pkw1; ldw = 128; col0 = 32 * dg; K = 2048; dbase = f ? W_P1V : W_P1K; }
        else { r -= 2 * I_P1; const int f = r >= I_P2; if (f) r -= I_P2; kb = r / 2; dg = r % 2; src = f ? pvw2 : pkw2; ldw = 64; col0 = 32 * dg; K = 128; dbase = f ? W_P2V : W_P2K; }
        transpose_item(src, ldw, col0, kb * 64, (bf16_t*)(ws + dbase) + (size_t)dg * 32 * K + kb * 64, K, scr, lane);
    }
    { const float* sw = a->in[18] + (size_t)l * 4 * 128 * 128; bf16_t* o = (bf16_t*)(ws + W_SGU);
      for (int i = bid * NTHR + tid; i < 4 * 128 * 128; i += G * NTHR) { const int t = (i >> 7) & 127, s = i & 127; o[i] = (bf16_t)f2bf(s <= t ? sw[i] : 0.f); } }
    for (int o = gw; o < 256; o += NGW) {
        const int which = o >> 7, c = o & 127;
        const float* pos = a->in[which ? 13 : 10] + (size_t)l * 2048; const float* w1 = which ? pvw1 : pkw1;
        float s = 0.f;
        for (int kk = lane; kk < 2048; kk += 64) s += pos[kk] * w1[(size_t)kk * 128 + c];
        s = wave_sum(s);
        if (lane == 0) ((float*)(ws + W_PB))[o] = s;
    }
    if (l == 0) {
        const f32x4* x4 = (const f32x4*)a->in[0]; u32x2* xb = (u32x2*)(ws + WS_XB);
        for (size_t i = (size_t)bid * NTHR + tid; i < (size_t)S * D / 4; i += (size_t)G * NTHR) { const f32x4 v = x4[i]; u32x2 w; w.x = pk2(v[0], v[1]); w.y = pk2(v[2], v[3]); xb[i] = w; }
        float* ct = (float*)(ws + WS_COS); float* st = (float*)(ws + WS_SIN);
        for (int i = bid * NTHR + tid; i < S * 32; i += G * NTHR) {
            const int t = i >> 5, d = i & 31;
            const float angf = (float)t * a->inv[d];
            const double ang = (double)angf;
            const double kq = rint(ang * 0.63661977236758134308);
            const double rr = (ang - kq * 1.57079632673412561417) - kq * 6.07710050650619224932e-11;
            const double r2 = rr * rr;
#define DC(x) ([](double v_) { asm volatile("" : "+s"(v_)); return v_; }(x))
            double sn = DC(1.0 / 6227020800.0); sn = sn * r2 + DC(-1.0 / 39916800); sn = sn * r2 + DC(1.0 / 362880); sn = sn * r2 + DC(-1.0 / 5040); sn = sn * r2 + DC(1.0 / 120); sn = sn * r2 + DC(-1.0 / 6); sn = rr + rr * r2 * sn;
            double cs = DC(-1.0 / 87178291200.0); cs = cs * r2 + DC(1.0 / 479001600); cs = cs * r2 + DC(-1.0 / 3628800); cs = cs * r2 + DC(1.0 / 40320); cs = cs * r2 + DC(-1.0 / 720); cs = cs * r2 + DC(1.0 / 24); cs = cs * r2 + DC(-0.5); cs = 1.0 + r2 * cs;
#undef DC
            const int qd = ((int)kq) & 3;
            const double c = qd == 0 ? cs : qd == 1 ? -sn : qd == 2 ? -cs : sn;
            const double s = qd == 0 ? sn : qd == 1 ? cs : qd == 2 ? -sn : -cs;
            ct[i] = (float)c; st[i] = (float)s;
        }
    }
}

__device__ __forceinline__ void ln_phase(const float* V, const float* gam, const float* bet, float* X, bf16_t* XB, int tid, int bid, int G) {
    const int lane = tid & 63, wave = tid >> 6;
    const int gw = bid * 8 + wave, NGW = G * 8;
    f32x4 gv[4], bv[4];
#pragma unroll
    for (int j = 0; j < 4; ++j) { gv[j] = ((const f32x4*)gam)[64 * j + lane]; bv[j] = ((const f32x4*)bet)[64 * j + lane]; }
    for (int m = gw; m < S; m += NGW) {
        const f32x4* xr = (const f32x4*)(V + (size_t)m * D) + lane;
        f32x4 v[4]; float s = 0.f;
#pragma unroll
        for (int j = 0; j < 4; ++j) { v[j] = xr[64 * j]; s += (v[j][0] + v[j][1]) + (v[j][2] + v[j][3]); }
        const float mean = wave_sum(s) * (1.f / D); float s2 = 0.f;
#pragma unroll
        for (int j = 0; j < 4; ++j) { v[j] = v[j] - mean; s2 += (v[j][0] * v[j][0] + v[j][1] * v[j][1]) + (v[j][2] * v[j][2] + v[j][3] * v[j][3]); }
        const float rstd = 1.0f / sqrtf(wave_sum(s2) * (1.f / D) + LN_EPS);
        f32x4* xo = (f32x4*)(X + (size_t)m * D) + lane; u32x2* bo = (u32x2*)(XB + (size_t)m * D) + lane;
#pragma unroll
        for (int j = 0; j < 4; ++j) { const f32x4 y = v[j] * rstd * gv[j] + bv[j]; xo[64 * j] = y; u32x2 w; w.x = pk2(y[0], y[1]); w.y = pk2(y[2], y[3]); bo[64 * j] = w; }
    }
}

constexpr int RP = 144;
struct KFrag { bf16x8 a0, a1, b0, b1; };
__device__ __forceinline__ KFrag load_kfrag(LAS const unsigned char* Kt, int lane) {
    const int r = lane & 15, g = lane >> 4;
    LAS const unsigned char* ka = Kt + (8 * (r >> 2) + (r & 3)) * RP + g * 16;
    KFrag k; k.a0 = *(LAS const bf16x8*)ka; k.a1 = *(LAS const bf16x8*)(ka + 64); k.b0 = *(LAS const bf16x8*)(ka + 4 * RP); k.b1 = *(LAS const bf16x8*)(ka + 4 * RP + 64);
    return k;
}
__device__ __forceinline__ void load_vfrag(bf16x8 (&vf)[4], LAS const unsigned char* Vt, int lane) {
    const int r = lane & 15, g = lane >> 4;
    LAS const unsigned char* vb = Vt + (8 * g + (r >> 2)) * RP + (lane & 3) * 8;
#pragma unroll
    for (int c = 0; c < 4; ++c) vf[c] = cat8(tr_read(vb + c * 32), tr_read(vb + 4 * RP + c * 32));
}
__device__ __forceinline__ void scores8(float (&s)[8], const KFrag& k, const bf16x8 (&qf)[2]) {
    const f32x4 z = {0.f, 0.f, 0.f, 0.f};
    f32x4 sa = mfma16(k.a0, qf[0], z); sa = mfma16(k.a1, qf[1], sa);
    f32x4 sb = mfma16(k.b0, qf[0], z); sb = mfma16(k.b1, qf[1], sb);
    s[0] = sa[0]; s[1] = sa[1]; s[2] = sa[2]; s[3] = sa[3]; s[4] = sb[0]; s[5] = sb[1]; s[6] = sb[2]; s[7] = sb[3];
}
__device__ __forceinline__ float rmax4(float v) { v = fmaxf(v, __shfl_xor(v, 16)); return fmaxf(v, __shfl_xor(v, 32)); }
__device__ __forceinline__ float rsum4(float v) { v += __shfl_xor(v, 16); return v + __shfl_xor(v, 32); }

__device__ __forceinline__ void attn_tile_step(float& m, float& l, f32x4 (&o)[4], const bf16x8 (&qf)[2], const KFrag& k, const bf16x8 (&vf)[4], unsigned vmask) {
    float s[8]; scores8(s, k, qf);
    float mx = -1e30f;
#pragma unroll
    for (int e = 0; e < 8; ++e) { s[e] = ((vmask >> e) & 1u) ? s[e] * QK_SC : -1e30f; mx = fmaxf(mx, s[e]); }
    mx = rmax4(mx);
    const float mn = fmaxf(m, mx), corr = fexp2(m - mn);
    float p[8], rs = 0.f;
#pragma unroll
    for (int e = 0; e < 8; ++e) { p[e] = ((vmask >> e) & 1u) ? fexp2(s[e] - mn) : 0.f; rs += p[e]; }
    rs = rsum4(rs);
    l = l * corr + rs; m = mn;
    const bf16x8 pf = pack8(p);
#pragma unroll
    for (int c = 0; c < 4; ++c) { o[c] = o[c] * corr; o[c] = mfma16(vf[c], pf, o[c]); }
}

__device__ __forceinline__ void win_phase(unsigned char* ws, LAS unsigned char* lds, int tid, int bid, int G) {
    const int lane = tid & 63, wave = tid >> 6, r = lane & 15, g = lane >> 4;
    const bf16_t* Q = (const bf16_t*)(ws + WS_QAT); const bf16_t* Kg = (const bf16_t*)(ws + WS_KW); const bf16_t* Vg = (const bf16_t*)(ws + WS_VW);
    const float* GA = (const float*)(ws + WS_GA); float* OA32 = (float*)(ws + WS_OA32);
    LAS unsigned char* Kl = lds; LAS unsigned char* Vl = lds + 128 * RP;
    for (int u = bid; u < 512; u += G) {
        const int tile = u >> 1, grp = u & 1, t0 = tile * 64;
        const int kstart = t0 >= 512 ? t0 - 512 : 0, kend = t0 + 64;
        const int tw = t0 + 8 * wave;
        bf16x8 qf[2][2]; float m[2], l[2]; f32x4 o[2][4];
#pragma unroll
        for (int qt = 0; qt < 2; ++qt) {
            const int tok = tw + 4 * qt + (r >> 2), head = r & 3;
            const bf16_t* qp = Q + (size_t)tok * 512 + (grp * 4 + head) * 64 + 8 * g;
            qf[qt][0] = *(const bf16x8*)qp; qf[qt][1] = *(const bf16x8*)(qp + 32);
            m[qt] = -1e30f; l[qt] = 0.f;
#pragma unroll
            for (int c = 0; c < 4; ++c) o[qt][c] = (f32x4){0.f, 0.f, 0.f, 0.f};
        }
        for (int kc = kstart; kc < kend; kc += 128) {
            const int nrows = (kend - kc) < 128 ? (kend - kc) : 128;
            __syncthreads();
            for (int c = tid; c < nrows * 8; c += NTHR) { const int i = c >> 3, pc = c & 7;
                *(LAS u32x4*)(Kl + i * RP + pc * 16) = *(const u32x4*)(Kg + (size_t)(kc + i) * 128 + grp * 64 + pc * 8);
                *(LAS u32x4*)(Vl + i * RP + pc * 16) = *(const u32x4*)(Vg + (size_t)(kc + i) * 128 + grp * 64 + pc * 8); }
            __syncthreads();
            for (int st = 0; st < nrows / 32; ++st) {
                const int k0 = kc + 32 * st;
                if (k0 + 31 < tw - 511 || k0 > tw + 7) continue;
                const KFrag kf = load_kfrag(Kl + st * 32 * RP, lane);
                bf16x8 vf[4]; load_vfrag(vf, Vl + st * 32 * RP, lane);
#pragma unroll
                for (int qt = 0; qt < 2; ++qt) {
                    const int t = tw + 4 * qt + (r >> 2); unsigned vm = 0;
#pragma unroll
                    for (int e = 0; e < 8; ++e) { const int dlt = t - (k0 + 8 * g + e); vm |= (dlt >= 0 && dlt < 512) ? (1u << e) : 0u; }
                    attn_tile_step(m[qt], l[qt], o[qt], qf[qt], kf, vf, vm);
                }
            }
        }
#pragma unroll
        for (int qt = 0; qt < 2; ++qt) {
            const int tok = tw + 4 * qt + (r >> 2), head = r & 3, hh = grp * 4 + head;
            const float sc = GA[(size_t)tok * 24 + hh * 3 + 2] / fmaxf(l[qt], 1e-30f);
#pragma unroll
            for (int c = 0; c < 4; ++c) *(f32x4*)(OA32 + (size_t)tok * 512 + hh * 64 + 16 * c + 4 * g) = o[qt][c] * sc;
        }
    }
}

__device__ __forceinline__ void dil_phase(unsigned char* ws, LAS unsigned char* lds, int tid, int bid, int G) {
    const int lane = tid & 63, wave = tid >> 6, r = lane & 15, g = lane >> 4;
    const bf16_t* Q = (const bf16_t*)(ws + WS_QB); const bf16_t* Kg = (const bf16_t*)(ws + WS_KB); const bf16_t* Vg = (const bf16_t*)(ws + WS_VB);
    bf16_t* OD = (bf16_t*)(ws + WS_OD); float* LSE = (float*)(ws + WS_LSE);
    LAS unsigned char* Kl = lds; LAS unsigned char* Vl = lds + 256 * RP;
    for (int u = bid; u < 1536; u += G) {
        const int h = u >> 7, rem = u & 127, gi = h >> 2, hi = h & 3, dil = 1 << (2 * gi), nsub = 128 >> (2 * gi), rr = rem / nsub, n = rem % nsub;
        const int mbase = 128 * n - 128;
        __syncthreads();
        for (int c = tid; c < 256 * 8; c += NTHR) { const int i = c >> 3, pc = c & 7; const int mk = mbase + i;
            u32x4 kv = {0, 0, 0, 0}, vv = {0, 0, 0, 0};
            if (mk >= 0) { const size_t off = (size_t)(mk * dil + rr) * 768 + h * 64 + pc * 8; kv = *(const u32x4*)(Kg + off); vv = *(const u32x4*)(Vg + off); }
            *(LAS u32x4*)(Kl + i * RP + pc * 16) = kv; *(LAS u32x4*)(Vl + i * RP + pc * 16) = vv; }
        __syncthreads();
        const int mq = 128 * n + 16 * wave + r, tq = mq * dil + rr;
        bf16x8 qf[2]; { const bf16_t* qp = Q + (size_t)tq * 768 + h * 64 + 8 * g; qf[0] = *(const bf16x8*)qp; qf[1] = *(const bf16x8*)(qp + 32); }
        float m = -1e30f, l = 0.f; f32x4 o[4];
#pragma unroll
        for (int c = 0; c < 4; ++c) o[c] = (f32x4){0.f, 0.f, 0.f, 0.f};
        const int start = (16 * wave) & ~31;
        for (int st = 0; st < 5; ++st) {
            const int i0 = start + 32 * st;
            const KFrag kf = load_kfrag(Kl + i0 * RP, lane);
            bf16x8 vf[4]; load_vfrag(vf, Vl + i0 * RP, lane);
            unsigned vm = 0;
#pragma unroll
            for (int e = 0; e < 8; ++e) { const int mk = mbase + i0 + 8 * g + e; const int dlt = mq - mk; vm |= (dlt >= 0 && dlt <= 128 && mk >= 0) ? (1u << e) : 0u; }
            attn_tile_step(m, l, o, qf, kf, vf, vm);
        }
        const float il = 1.0f / fmaxf(l, 1e-30f);
        bf16_t* op = OD + ((size_t)gi * S + tq) * 256 + hi * 64 + 4 * g;
#pragma unroll
        for (int c = 0; c < 4; ++c) { u32x2 w; w.x = pk2(o[c][0] * il, o[c][1] * il); w.y = pk2(o[c][2] * il, o[c][3] * il); *(u32x2*)(op + 16 * c) = w; }
        if (g == 0) LSE[((size_t)gi * S + tq) * 4 + hi] = m + log2f(fmaxf(l, 1e-30f));
    }
}
__device__ __forceinline__ void dil_combine(unsigned char* ws, int tid, int bid, int G) {
    const bf16_t* OD = (const bf16_t*)(ws + WS_OD); const float* LSE = (const float*)(ws + WS_LSE); bf16_t* OB = (bf16_t*)(ws + WS_OB);
    for (int i = bid * NTHR + tid; i < S * 32; i += G * NTHR) {
        const int t = i >> 5, hi = (i >> 3) & 3, ch = i & 7;
        const float l0 = LSE[(size_t)t * 4 + hi], l1 = LSE[((size_t)S + t) * 4 + hi], l2 = LSE[((size_t)2 * S + t) * 4 + hi];
        const float mx = fmaxf(l0, fmaxf(l1, l2));
        float w0 = fexp2(l0 - mx), w1 = fexp2(l1 - mx), w2 = fexp2(l2 - mx); const float iw = 1.0f / (w0 + w1 + w2); w0 *= iw; w1 *= iw; w2 *= iw;
        const size_t off = (size_t)t * 256 + hi * 64 + ch * 8;
        const u32x4 a = *(const u32x4*)(OD + off), b = *(const u32x4*)(OD + (size_t)S * 256 + off), c = *(const u32x4*)(OD + (size_t)2 * S * 256 + off);
        u32x4 w;
        w.x = pk2(w0 * bflo(a.x) + w1 * bflo(b.x) + w2 * bflo(c.x), w0 * bfhi(a.x) + w1 * bfhi(b.x) + w2 * bfhi(c.x));
        w.y = pk2(w0 * bflo(a.y) + w1 * bflo(b.y) + w2 * bflo(c.y), w0 * bfhi(a.y) + w1 * bfhi(b.y) + w2 * bfhi(c.y));
        w.z = pk2(w0 * bflo(a.z) + w1 * bflo(b.z) + w2 * bflo(c.z), w0 * bfhi(a.z) + w1 * bfhi(b.z) + w2 * bfhi(c.z));
        w.w = pk2(w0 * bflo(a.w) + w1 * bflo(b.w) + w2 * bflo(c.w), w0 * bfhi(a.w) + w1 * bfhi(b.w) + w2 * bfhi(c.w));
        *(u32x4*)(OB + off) = w;
    }
}

__device__ __forceinline__ void sgu_phase(ArgsP a, unsigned char* ws, int l, LAS unsigned char* lds, int tid, int bid, int G) {
    constexpr int VRP = 272;
    const int lane = tid & 63, wave = tid >> 6, r = lane & 15, g = lane >> 4;
    const bf16_t* UVG = (const bf16_t*)(ws + WS_UVG); bf16_t* OC = (bf16_t*)(ws + WS_OC); const bf16_t* WSB = (const bf16_t*)(ws + W_SGU);
    const float* lng = a->in[16] + (size_t)l * 512; const float* lnb = a->in[17] + (size_t)l * 512; const float* sb = a->in[19] + (size_t)l * 512;
    LAS unsigned char* vh = lds;
    for (int u = bid; u < 512; u += G) {
        const int n = u >> 2, grp = u & 3, t0 = n * 128;
        __syncthreads();
        for (int tt = 0; tt < 16; ++tt) {
            const int tl = 16 * wave + tt;
            const u32x4 w = *(const u32x4*)(UVG + (size_t)(t0 + tl) * 1024 + 512 + 8 * lane);
            float v[8] = {bflo(w.x), bfhi(w.x), bflo(w.y), bfhi(w.y), bflo(w.z), bfhi(w.z), bflo(w.w), bfhi(w.w)};
            float s = 0.f;
#pragma unroll
            for (int e = 0; e < 8; ++e) s += v[e];
            const float mean = wave_sum(s) * (1.f / 512); float s2 = 0.f;
#pragma unroll
            for (int e = 0; e < 8; ++e) { v[e] -= mean; s2 += v[e] * v[e]; }
            const float rstd = 1.0f / sqrtf(wave_sum(s2) * (1.f / 512) + LN_EPS);
            if ((lane >> 4) == grp) {
                float y[8];
#pragma unroll
                for (int e = 0; e < 8; ++e) y[e] = v[e] * rstd * lng[8 * lane + e] + lnb[8 * lane + e];
                u32x4 o; o.x = pk2(y[0], y[1]); o.y = pk2(y[2], y[3]); o.z = pk2(y[4], y[5]); o.w = pk2(y[6], y[7]);
                *(LAS u32x4*)(vh + tl * VRP + (8 * lane - 128 * grp) * 2) = o;
            }
        }
        __syncthreads();
        f32x4 acc[8];
#pragma unroll
        for (int c = 0; c < 8; ++c) acc[c] = (f32x4){0.f, 0.f, 0.f, 0.f};
        const int nst = (16 * wave + 15) / 32 + 1;
        for (int ks = 0; ks < nst; ++ks) {
            const bf16x8 bfr = *(const bf16x8*)(WSB + ((size_t)grp * 128 + 16 * wave + r) * 128 + 32 * ks + 8 * g);
            LAS const unsigned char* vb = vh + (32 * ks + 8 * g + (r >> 2)) * VRP + (lane & 3) * 8;
#pragma unroll
            for (int c = 0; c < 8; ++c) { const bf16x8 af = cat8(tr_read(vb + c * 32), tr_read(vb + 4 * VRP + c * 32)); acc[c] = mfma16(af, bfr, acc[c]); }
        }
        const int tl = 16 * wave + r; const float bias = sb[grp * 128 + tl];
        const bf16_t* up = UVG + (size_t)(t0 + tl) * 1024 + grp * 128 + 4 * g; bf16_t* op = OC + (size_t)(t0 + tl) * 512 + grp * 128 + 4 * g;
#pragma unroll
        for (int c = 0; c < 8; ++c) { const u32x2 uw = *(const u32x2*)(up + 16 * c);
            u32x2 w; w.x = pk2(bflo(uw.x) * (acc[c][0] + bias), bfhi(uw.x) * (acc[c][1] + bias)); w.y = pk2(bflo(uw.y) * (acc[c][2] + bias), bfhi(uw.y) * (acc[c][3] + bias));
            *(u32x2*)(op + 16 * c) = w; }
    }
}

__device__ __forceinline__ void cmp_mlp_phase(unsigned char* ws, LAS unsigned char* lds, int tid, int bid, int G) {
    const int lane = tid & 63, wave = tid >> 6, r = lane & 15, g = lane >> 4;
    LAS float* red = (LAS float*)lds; LAS unsigned char* hid = lds + 65536;
    for (int u = bid; u < 256; u += G) {
        const int which = u >> 7, grp = (u >> 6) & 1, rt = u & 63;
        const bf16_t* src = (const bf16_t*)(ws + (which ? WS_VC : WS_KC)); const bf16_t* w1t = (const bf16_t*)(ws + (which ? W_P1V : W_P1K)); const bf16_t* w2t = (const bf16_t*)(ws + (which ? W_P2V : W_P2K));
        const float* pb = (const float*)(ws + W_PB) + which * 128; bf16_t* dst = (bf16_t*)(ws + (which ? WS_VCMP : WS_KCMP));
        f32x4 acc[8];
#pragma unroll
        for (int c = 0; c < 8; ++c) acc[c] = (f32x4){0.f, 0.f, 0.f, 0.f};
        for (int ks = 0; ks < 8; ++ks) {
            const int j = 4 * wave + (ks >> 1), d0 = (ks & 1) * 32 + 8 * g, tok = 16 * (16 * rt + r) + j;
            bf16x8 af = {0, 0, 0, 0, 0, 0, 0, 0};
            if (tok < S) af = *(const bf16x8*)(src + (size_t)tok * 128 + grp * 64 + d0);
#pragma unroll
            for (int c = 0; c < 8; ++c) { const bf16x8 bfr = *(const bf16x8*)(w1t + (size_t)(16 * c + r) * 2048 + 256 * wave + 32 * ks + 8 * g); acc[c] = mfma16(af, bfr, acc[c]); }
        }
        __syncthreads();
#pragma unroll
        for (int c = 0; c < 8; ++c)
#pragma unroll
            for (int i = 0; i < 4; ++i) red[wave * 2048 + (4 * g + i) * 128 + 16 * c + r] = acc[c][i];
        __syncthreads();
#pragma unroll
        for (int q = 0; q < 4; ++q) { const int idx = tid * 4 + q, row = idx >> 7, col = idx & 127; float s = pb[col];
#pragma unroll
            for (int w = 0; w < 8; ++w) s += red[w * 2048 + idx];
            *(LAS bf16_t*)(hid + row * 272 + col * 2) = (bf16_t)f2bf(gelu_tanh(s)); }
        __syncthreads();
        if (wave < 4) {
            f32x4 a2 = {0.f, 0.f, 0.f, 0.f};
#pragma unroll
            for (int ks = 0; ks < 4; ++ks) { const bf16x8 af = *(LAS const bf16x8*)(hid + r * 272 + (32 * ks + 8 * g) * 2); const bf16x8 bfr = *(const bf16x8*)(w2t + (size_t)(16 * wave + r) * 128 + 32 * ks + 8 * g); a2 = mfma16(af, bfr, a2); }
#pragma unroll
            for (int i = 0; i < 4; ++i) dst[((size_t)grp * 1024 + 16 * rt + 4 * g + i) * 64 + 16 * wave + r] = (bf16_t)f2bf(a2[i]);
        }
    }
}

__device__ __forceinline__ void cmp_attn_phase(unsigned char* ws, LAS unsigned char* lds, int tid, int bid, int G) {
    const int lane = tid & 63, wave = tid >> 6, r = lane & 15, g = lane >> 4;
    const bf16_t* Q = (const bf16_t*)(ws + WS_QAR); const float* GA = (const float*)(ws + WS_GA); const float* OA32 = (const float*)(ws + WS_OA32); float* OA32B = (float*)(ws + WS_OA32B); unsigned* SEL = (unsigned*)(ws + WS_SEL);
    LAS unsigned char* Kl = lds; LAS unsigned char* Vl = lds + 128 * RP; LAS float* pslc = (LAS float*)(lds + 65536);
    for (int u = bid; u < 1024; u += G) {
        const int ux = (u & 255) >> 1, uk = u >> 8, tile = uk == 0 ? ux : (uk == 1 ? 255 - ux : (uk == 2 ? 256 + ux : 511 - ux)), grp = u & 1, t0 = tile * 32;
        const bf16_t* Kg = (const bf16_t*)(ws + WS_KCMP) + (size_t)grp * 1024 * 64; const bf16_t* Vg = (const bf16_t*)(ws + WS_VCMP) + (size_t)grp * 1024 * 64;
        const int nk = t0 / 16 + 1;
        const int tokl = 4 * wave + (r >> 2), tok = t0 + tokl, head = r & 3, hh = grp * 4 + head;
        bf16x8 qf[2]; { const bf16_t* qp = Q + (size_t)tok * 512 + hh * 64 + 8 * g; qf[0] = *(const bf16x8*)qp; qf[1] = *(const bf16x8*)(qp + 32); }
        __syncthreads();
        for (int i = tid; i < 32 * 256; i += NTHR) pslc[i] = 0.f;
        float m = -1e30f, l = 0.f;
        const int crow = tid >> 3, cpc = tid & 7;
        u32x4 kr0, kr1, vr0, vr1;
        kr0 = *(const u32x4*)(Kg + (size_t)crow * 64 + cpc * 8); kr1 = *(const u32x4*)(Kg + (size_t)(crow + 64) * 64 + cpc * 8);
        for (int kc = 0; kc < nk; kc += 128) {
            __syncthreads();
            *(LAS u32x4*)(Kl + crow * RP + cpc * 16) = kr0; *(LAS u32x4*)(Kl + (crow + 64) * RP + cpc * 16) = kr1;
            __syncthreads();
            { const int kn = (kc + 128 < nk) ? kc + 128 : 0;
              kr0 = *(const u32x4*)(Kg + (size_t)(kn + crow) * 64 + cpc * 8); kr1 = *(const u32x4*)(Kg + (size_t)(kn + crow + 64) * 64 + cpc * 8); }
            const int nst = ((nk - kc) < 128 ? (nk - kc) : 128);
            for (int st = 0; st * 32 < nst; ++st) {
                const KFrag kf = load_kfrag(Kl + st * 32 * RP, lane);
                float s[8]; scores8(s, kf, qf);
                float mx = -1e30f; unsigned vm = 0;
#pragma unroll
                for (int e = 0; e < 8; ++e) { const int nn = kc + 32 * st + 8 * g + e; const bool ok = 16 * nn + 31 <= tok; vm |= ok ? (1u << e) : 0u; s[e] = ok ? s[e] * QK_SC : -1e30f; mx = fmaxf(mx, s[e]); }
                mx = rmax4(mx);
                const float mn = fmaxf(m, mx); float rs = 0.f;
#pragma unroll
                for (int e = 0; e < 8; ++e) rs += ((vm >> e) & 1u) ? fexp2(s[e] - mn) : 0.f;
                rs = rsum4(rs);
                l = l * fexp2(m - mn) + rs; m = mn;
            }
        }
        const float il = 1.0f / fmaxf(l, 1e-30f);
        f32x4 o[4];
#pragma unroll
        for (int c = 0; c < 4; ++c) o[c] = (f32x4){0.f, 0.f, 0.f, 0.f};
        vr0 = *(const u32x4*)(Vg + (size_t)crow * 64 + cpc * 8); vr1 = *(const u32x4*)(Vg + (size_t)(crow + 64) * 64 + cpc * 8);
        for (int kc = 0; kc < nk; kc += 128) {
            __syncthreads();
            *(LAS u32x4*)(Kl + crow * RP + cpc * 16) = kr0; *(LAS u32x4*)(Kl + (crow + 64) * RP + cpc * 16) = kr1;
            *(LAS u32x4*)(Vl + crow * RP + cpc * 16) = vr0; *(LAS u32x4*)(Vl + (crow + 64) * RP + cpc * 16) = vr1;
            __syncthreads();
            if (kc + 128 < nk) { const int kn = kc + 128;
              kr0 = *(const u32x4*)(Kg + (size_t)(kn + crow) * 64 + cpc * 8); kr1 = *(const u32x4*)(Kg + (size_t)(kn + crow + 64) * 64 + cpc * 8);
              vr0 = *(const u32x4*)(Vg + (size_t)(kn + crow) * 64 + cpc * 8); vr1 = *(const u32x4*)(Vg + (size_t)(kn + crow + 64) * 64 + cpc * 8); }
            const int nst = ((nk - kc) < 128 ? (nk - kc) : 128);
            for (int st = 0; st * 32 < nst; ++st) {
                const KFrag kf = load_kfrag(Kl + st * 32 * RP, lane);
                bf16x8 vf[4]; load_vfrag(vf, Vl + st * 32 * RP, lane);
                float s[8]; scores8(s, kf, qf);
                float p[8];
#pragma unroll
                for (int e = 0; e < 8; ++e) { const int nn = kc + 32 * st + 8 * g + e; const bool ok = 16 * nn + 31 <= tok; p[e] = ok ? fexp2(s[e] * QK_SC - m) * il : 0.f; }
                const bf16x8 pf = pack8(p);
#pragma unroll
                for (int c = 0; c < 4; ++c) o[c] = mfma16(vf[c], pf, o[c]);
                float A = (p[0] + p[1]) + (p[2] + p[3]), B = p[3] + (p[4] + p[5]) + (p[6] + p[7]), C = p[7];
                A += __shfl_xor(A, 1); A += __shfl_xor(A, 2); B += __shfl_xor(B, 1); B += __shfl_xor(B, 2); C += __shfl_xor(C, 1); C += __shfl_xor(C, 2);
                if ((lane & 3) == 0) {
                    const int j0 = (kc + 32 * st) / 4 + 2 * g; float* pp = (float*)(pslc + tokl * 256);
                    atomicAdd(pp + j0, A);
                    if (j0 + 1 < 256) atomicAdd(pp + j0 + 1, B);
                    if (j0 + 2 < 256) atomicAdd(pp + j0 + 2, C);
                }
            }
        }
        { const float sc = GA[(size_t)tok * 24 + hh * 3 + 0];
#pragma unroll
          for (int c = 0; c < 4; ++c) { const size_t off = (size_t)tok * 512 + hh * 64 + 16 * c + 4 * g; *(f32x4*)(OA32B + off) = *(const f32x4*)(OA32 + off) + o[c] * sc; } }
        __syncthreads();
        {
            const unsigned long long lt = (1ull << lane) - 1ull;
#pragma unroll
            for (int tk = 0; tk < 4; ++tk) {
                const int tl = 4 * wave + tk, t = t0 + tl, cur = t >> 6;
                unsigned key[4];
#pragma unroll
                for (int i = 0; i < 4; ++i) { const int j = lane + 64 * i;
                    key[i] = (j > cur) ? 0u : ((j == 0 || j == cur || j == cur - 1) ? 0x7f800000u : (__builtin_bit_cast(unsigned, pslc[tl * 256 + j]) + 1u)); }
                unsigned T = 0;
                for (int bit = 30; bit >= 0; --bit) {
                    const unsigned cand = T | (1u << bit);
                    const int cnt = __builtin_popcountll(__ballot(key[0] >= cand)) + __builtin_popcountll(__ballot(key[1] >= cand)) + __builtin_popcountll(__ballot(key[2] >= cand)) + __builtin_popcountll(__ballot(key[3] >= cand));
                    if (cnt >= 16) T = cand;
                }
                bool sel[4]; int c1 = 0;
#pragma unroll
                for (int i = 0; i < 4; ++i) { sel[i] = key[i] > T; c1 += __builtin_popcountll(__ballot(sel[i])); }
                if (T > 0u) { const int need = 16 - c1; int run = 0;
#pragma unroll
                    for (int i = 0; i < 4; ++i) { const bool eq = key[i] == T; const unsigned long long bm = __ballot(eq); const int rank = run + __builtin_popcountll(bm & lt); sel[i] = sel[i] || (eq && rank < need); run += __builtin_popcountll(bm); } }
#pragma unroll
                for (int i = 0; i < 4; ++i) { const unsigned long long bm = __ballot(sel[i]);
                    if (lane == 0) { SEL[((size_t)t * 2 + grp) * 8 + 2 * i] = (unsigned)bm; SEL[((size_t)t * 2 + grp) * 8 + 2 * i + 1] = (unsigned)(bm >> 32); } }
            }
        }
    }
}

__device__ __forceinline__ void slc_phase(unsigned char* ws, LAS unsigned char* lds, int tid, int bid, int G) {
    const int lane = tid & 63, wave = tid >> 6, r = lane & 15, g = lane >> 4;
    const bf16_t* Q = (const bf16_t*)(ws + WS_QAT); const bf16_t* Kg = (const bf16_t*)(ws + WS_KS); const bf16_t* Vg = (const bf16_t*)(ws + WS_VS);
    const float* GA = (const float*)(ws + WS_GA); const float* OA32 = (const float*)(ws + WS_OA32B); bf16_t* OA = (bf16_t*)(ws + WS_OA); const unsigned* SEL = (const unsigned*)(ws + WS_SEL);
    constexpr int KVB = 128 * RP;
    LAS unsigned* selm = (LAS unsigned*)(lds + 4 * KVB); LAS unsigned* uni = (LAS unsigned*)(lds + 4 * KVB + 2048); LAS unsigned* blist = (LAS unsigned*)(lds + 4 * KVB + 4096);
    for (int u = bid; u < 512; u += G) {
        const int ux = (u & 255) >> 1, tile = (u < 256) ? ux : 255 - ux, grp = u & 1, t0 = tile * 64, cur = tile;
        __syncthreads();
        selm[tid] = SEL[((size_t)(t0 + (tid >> 3)) * 2 + grp) * 8 + (tid & 7)];
        __syncthreads();
        if (tid < 8) { unsigned x = 0; for (int i = 0; i < 64; ++i) x |= selm[i * 8 + tid]; uni[tid] = x; }
        __syncthreads();
        if (tid < 256) {
            const int wq = tid >> 5; unsigned below = 0, total = 0;
#pragma unroll
            for (int w = 0; w < 8; ++w) { const unsigned x = uni[w]; const unsigned pc = __builtin_popcount(x); total += pc; below += (w < wq) ? pc : 0u; }
            const unsigned mine = uni[wq];
            if ((mine >> (tid & 31)) & 1u) blist[below + __builtin_popcount(mine & ((1u << (tid & 31)) - 1u))] = tid;
            if (tid == 0) blist[256] = total;
        }
        __syncthreads();
        const int nblk = __builtin_amdgcn_readfirstlane((int)blist[256]);
        const int tw = t0 + 8 * wave;
        bf16x8 qf[2][2]; float mr[2], l[2]; f32x4 o[2][4]; unsigned mw[2][8];
#pragma unroll
        for (int qt = 0; qt < 2; ++qt) {
            const int tok = tw + 4 * qt + (r >> 2), head = r & 3;
            const bf16_t* qp = Q + (size_t)tok * 512 + (grp * 4 + head) * 64 + 8 * g; const bf16_t* kp = Kg + (size_t)tok * 128 + grp * 64 + 8 * g;
            qf[qt][0] = *(const bf16x8*)qp; qf[qt][1] = *(const bf16x8*)(qp + 32);
            float d = 0.f;
#pragma unroll
            for (int hf = 0; hf < 2; ++hf) { const u32x4 a = __builtin_bit_cast(u32x4, qf[qt][hf]); const u32x4 b = *(const u32x4*)(kp + 32 * hf);
                d += bflo(a.x) * bflo(b.x) + bfhi(a.x) * bfhi(b.x) + bflo(a.y) * bflo(b.y) + bfhi(a.y) * bfhi(b.y) + bflo(a.z) * bflo(b.z) + bfhi(a.z) * bfhi(b.z) + bflo(a.w) * bflo(b.w) + bfhi(a.w) * bfhi(b.w); }
            mr[qt] = rsum4(d) * QK_SC; l[qt] = 0.f;
#pragma unroll
            for (int c = 0; c < 4; ++c) o[qt][c] = (f32x4){0.f, 0.f, 0.f, 0.f};
#pragma unroll
            for (int w = 0; w < 8; ++w) mw[qt][w] = selm[(8 * wave + 4 * qt + (r >> 2)) * 8 + w];
        }
        const int srow = tid >> 3, spc = tid & 7;
        const int nrounds = (nblk + 3) >> 2;
        u32x4 kreg[4], vreg[4];
#pragma unroll
        for (int b = 0; b < 4; ++b) { kreg[b] = (u32x4){0, 0, 0, 0}; vreg[b] = (u32x4){0, 0, 0, 0};
            if (b < nblk) { const int jj = __builtin_amdgcn_readfirstlane((int)blist[b]); const size_t off = (size_t)(64 * jj + srow) * 128 + grp * 64 + spc * 8; kreg[b] = *(const u32x4*)(Kg + off); vreg[b] = *(const u32x4*)(Vg + off); } }
        for (int rd = 0; rd < nrounds; ++rd) {
            __syncthreads();
#pragma unroll
            for (int b = 0; b < 4; ++b) { LAS unsigned char* kb = lds + b * KVB; *(LAS u32x4*)(kb + srow * RP + spc * 16) = kreg[b]; *(LAS u32x4*)(kb + 64 * RP + srow * RP + spc * 16) = vreg[b]; }
            __syncthreads();
#pragma unroll
            for (int b = 0; b < 4; ++b) { const int jb = (rd + 1) * 4 + b;
                if (jb < nblk) { const int jj = __builtin_amdgcn_readfirstlane((int)blist[jb]); const size_t off = (size_t)(64 * jj + srow) * 128 + grp * 64 + spc * 8; kreg[b] = *(const u32x4*)(Kg + off); vreg[b] = *(const u32x4*)(Vg + off); } }
            for (int b = 0; b < 4; ++b) {
                const int jb = rd * 4 + b; if (jb >= nblk) break;
                const int j = __builtin_amdgcn_readfirstlane((int)blist[jb]);
                LAS unsigned char* Kl = lds + b * KVB; LAS unsigned char* Vl = Kl + 64 * RP;
                bool bit[2]; bool need[2];
#pragma unroll
                for (int qt = 0; qt < 2; ++qt) {
                    unsigned wsel = mw[qt][0];
#pragma unroll
                    for (int w = 1; w < 8; ++w) wsel = ((j >> 5) == w) ? mw[qt][w] : wsel;
                    bit[qt] = (wsel >> (j & 31)) & 1u; need[qt] = __ballot(bit[qt]) != 0ull;
                }
                if (need[0] || need[1]) {
                    const bool diag = (j == cur);
#pragma unroll
                    for (int st = 0; st < 2; ++st) {
                        const KFrag kf = load_kfrag(Kl + st * 32 * RP, lane);
                        bf16x8 vf[4]; load_vfrag(vf, Vl + st * 32 * RP, lane);
#pragma unroll
                        for (int qt = 0; qt < 2; ++qt) {
                            if (!need[qt]) continue;
                            const int t = tw + 4 * qt + (r >> 2);
                            float s[8], p[8]; scores8(s, kf, qf[qt]);
#pragma unroll
                            for (int e = 0; e < 8; ++e) { const int key = 64 * j + 32 * st + 8 * g + e; const bool ok = bit[qt] && (!diag || key <= t); p[e] = ok ? fexp2(s[e] * QK_SC - mr[qt]) : 0.f; l[qt] += p[e]; }
                            const bf16x8 pf = pack8(p);
#pragma unroll
                            for (int c = 0; c < 4; ++c) o[qt][c] = mfma16(vf[c], pf, o[qt][c]);
                        }
                    }
                }
            }
        }
#pragma unroll
        for (int qt = 0; qt < 2; ++qt) {
            const int tok = tw + 4 * qt + (r >> 2), head = r & 3, hh = grp * 4 + head;
            const float sc = GA[(size_t)tok * 24 + hh * 3 + 1] / fmaxf(rsum4(l[qt]), 1e-30f);
#pragma unroll
            for (int c = 0; c < 4; ++c) { const size_t off = (size_t)tok * 512 + hh * 64 + 16 * c + 4 * g; const f32x4 b = *(const f32x4*)(OA32 + off); const f32x4 v = b + o[qt][c] * sc;
                u32x2 w; w.x = pk2(v[0], v[1]); w.y = pk2(v[2], v[3]); *(u32x2*)(OA + off) = w; }
        }
    }
}

#define XB_TMO      128
#define XB_XCNT(j)  (256  + 64 * (j))
#define XB_XSUB(j)  (1280 + 64 * (j))
#define XB_XGEN(j)  (2304 + 64 * (j))
#define XB_TOP      3328
#define XB_TOPGEN   3392
#define XCD_BAR_WORDS 3456
#define XB_SPIN_CAP (1u << 18)

__device__ __forceinline__ unsigned xb_ld(unsigned* p)              { return __hip_atomic_load(p, __ATOMIC_RELAXED, __HIP_MEMORY_SCOPE_AGENT); }
__device__ __forceinline__ unsigned xb_add(unsigned* p, unsigned v) { return __hip_atomic_fetch_add(p, v, __ATOMIC_RELAXED, __HIP_MEMORY_SCOPE_AGENT); }
__device__ __forceinline__ unsigned xb_xcc_id() { return (unsigned)__builtin_amdgcn_s_getreg((3 << 11) | 20) & 0xFu; }
#define XB_SPIN(cond, bar) do { unsigned _sp = 0; while (cond) { __builtin_amdgcn_s_sleep(1); \
    if ((++_sp & 255u) == 0u) { if (xb_ld(&(bar)[XB_TMO])) break; if (_sp > XB_SPIN_CAP) { atomicAdd(&(bar)[XB_TMO], 1u); break; } } } } while (0)

struct XcdBarrier {
    unsigned* bar; unsigned x;
    volatile LAS unsigned* st;
};

__device__ __forceinline__ XcdBarrier xcd_barrier_post(unsigned* bar, volatile LAS unsigned* st) {
    XcdBarrier b; b.bar = bar; b.x = xb_xcc_id(); b.st = st;
    if (threadIdx.x == 0) (void)xb_add(&bar[XB_XCNT(b.x)], 1u);
    return b;
}
__device__ __forceinline__ void xcd_barrier_complete(unsigned* bar, unsigned x, unsigned& nloc, unsigned& nx) {
    const unsigned G = gridDim.x * gridDim.y * gridDim.z;
    unsigned sum, cnt, mine, sp = 0u;
    for (;;) {
        sum = 0u; cnt = 0u; mine = 0u;
#pragma unroll
        for (unsigned j = 0; j < 16; ++j) { const unsigned c = xb_ld(&bar[XB_XCNT(j)]); sum += c; cnt += (c > 0u) ? 1u : 0u; mine = (j == x) ? c : mine; }
        if (sum == G) break;
        __builtin_amdgcn_s_sleep(1);
        if ((++sp & 255u) == 0u) { if (xb_ld(&bar[XB_TMO])) break; if (sp > XB_SPIN_CAP) { atomicAdd(&bar[XB_TMO], 1u); break; } }
    }
    nloc = mine > 0u ? mine : 1u; nx = cnt > 0u ? cnt : 1u;
}

__device__ __forceinline__ void xcd_barrier(const XcdBarrier& b) {
    asm volatile("s_waitcnt vmcnt(0)" ::: "memory");
    __syncthreads();
    if (threadIdx.x == 0) {
        unsigned* bar = b.bar;
        __builtin_amdgcn_s_waitcnt(0);
        unsigned nloc = b.st[0], nx = b.st[1];
        if (nloc == 0u) { xcd_barrier_complete(bar, b.x, nloc, nx); b.st[0] = nloc; b.st[1] = nx; }
        const unsigned old = xb_add(&bar[XB_XSUB(b.x)], 1u);
        const unsigned gen = old / nloc;
        if (old + 1u == (gen + 1u) * nloc) {
            __builtin_amdgcn_fence(__ATOMIC_RELEASE, "agent");
            asm volatile("s_waitcnt vmcnt(0)" ::: "memory");
            const unsigned og = xb_add(&bar[XB_TOP], 1u);
            const unsigned tg = og / nx;
            if (og + 1u == (tg + 1u) * nx) xb_add(&bar[XB_TOPGEN], 1u);
            else XB_SPIN(xb_ld(&bar[XB_TOPGEN]) == tg, bar);
            __builtin_amdgcn_fence(__ATOMIC_ACQUIRE, "agent");
            xb_add(&bar[XB_XGEN(b.x)], 1u);
            asm volatile("s_waitcnt vmcnt(0)" ::: "memory");
        } else {
            XB_SPIN(xb_ld(&bar[XB_XGEN(b.x)]) == gen, bar);
            __builtin_amdgcn_fence(__ATOMIC_ACQUIRE, "agent");
            asm volatile("s_waitcnt vmcnt(0)" ::: "memory");
        }
    }
    __syncthreads();
}

__device__ __forceinline__ ArgsP opqa() { ArgsP p = (ArgsP)__builtin_amdgcn_kernarg_segment_ptr(); asm volatile("" : "+s"(p)); return p; }
#ifndef MIX_MASK
#define MIX_MASK 0xff
#endif
__global__ void __launch_bounds__(NTHR, 2) fwd_kernel(Args a) {
    extern __shared__ __attribute__((aligned(16))) unsigned char lds_raw[];
    LAS unsigned char* lds = (LAS unsigned char*)lds_raw;
    cg::grid_group grid = cg::this_grid();
    const int tid0 = threadIdx.x, bid0 = blockIdx.x, G0 = gridDim.x;
    volatile LAS unsigned* MISC = (volatile LAS unsigned*)(lds + LDS_BYTES - 64);
    if (tid0 < 16) MISC[tid0] = 0u;
    __syncthreads();
    { ArgsP ap0 = opqa(); (void)xcd_barrier_post((unsigned*)(ap0->ws + 16384), MISC); }
    #define GRID_BAR() do { ArgsP apb = opqa(); XcdBarrier xb_; xb_.bar = (unsigned*)(apb->ws + 16384); xb_.x = xb_xcc_id(); xb_.st = MISC; xcd_barrier(xb_); } while (0)
    #define WSP ArgsP ap = opqa(); int tid = tid0, bid = bid0, G = G0; asm volatile("" : "+v"(tid), "+s"(bid), "+s"(G)); unsigned char* ws = ap->ws; bf16_t* XB = (bf16_t*)(ws + WS_XB); float* V32 = (float*)(ws + WS_V32); bf16_t* H = (bf16_t*)(ws + WS_H); (void)XB; (void)V32; (void)H;
#pragma unroll 1
    for (int l0 = 0; l0 < DEPTH; ++l0) {
        int l = l0; asm volatile("" : "+s"(l));
        { WSP prologue_phase(ap, l, lds, tid, bid, G); }
        if (l == 0) grid.sync(); else GRID_BAR();
        { WSP pg8::Gemm g{XB, (const bf16_t*)(ws + W_GU1), S, 5632, 1024}; pg8::StaticOrder so; so.init(S, 5632, G, bid); EpiFfn e{H};
          pg8::gemm_phase<EpiFfn, pg8::StaticOrder, true, true>(lds, g, so, e); }
        GRID_BAR();
        { WSP pg8::Gemm g{H, (const bf16_t*)(ws + W_D1), S, 1024, FF}; pg8::StaticOrder so; so.init(S, 1024, G, bid); EpiRes e{l == 0 ? ap->in[0] : ap->out, V32, 0.5f};
          pg8::gemm_phase<EpiRes, pg8::StaticOrder, true, true>(lds, g, so, e); }
        GRID_BAR();
        { WSP ln_phase(V32, ap->in[1] + (size_t)l * 3 * D, ap->in[2] + (size_t)l * 3 * D, ap->out, XB, tid, bid, G); }
        GRID_BAR();
        { WSP pg8::Gemm g{XB, (const bf16_t*)(ws + W_IN), S, NZ, 1024}; pg8::StaticOrder so; so.init(S, NZ, G, bid); EpiZ e{ws};
          pg8::gemm_phase<EpiZ, pg8::StaticOrder, true, true>(lds, g, so, e); }
        GRID_BAR();
        { WSP cmp_mlp_phase(ws, lds, tid, bid, G); }
        { WSP sgu_phase(ap, ws, l, lds, tid, bid, G); }
        { WSP dil_phase(ws, lds, tid, bid, G); }
        { WSP win_phase(ws, lds, tid, bid, G); }
        GRID_BAR();
        { WSP dil_combine(ws, tid, bid, G); }
        { WSP cmp_attn_phase(ws, lds, tid, bid, G); }
        GRID_BAR();
        { WSP slc_phase(ws, lds, tid, bid, G); }
        GRID_BAR();
        { WSP pg8::Gemm g{(const bf16_t*)(ws + WS_OA), (const bf16_t*)(ws + W_A), S, 1024, 512}; pg8::StaticOrder so; so.init(S, 1024, G, bid); EpiGate e{(const bf16_t*)(ws + WS_GM), (float*)(ws + WS_M32), (bf16_t*)(ws + WS_MB), 0, 0};
          pg8::gemm_phase<EpiGate, pg8::StaticOrder, true, true>(lds, g, so, e); }
        { WSP pg8::Gemm g{(const bf16_t*)(ws + WS_OB), (const bf16_t*)(ws + W_B), S, 1024, 256}; pg8::StaticOrder so; so.init(S, 1024, G, bid); EpiGate e{(const bf16_t*)(ws + WS_GM), (float*)(ws + WS_M32), (bf16_t*)(ws + WS_MB), 1024, 1};
          pg8::gemm_phase<EpiGate, pg8::StaticOrder, true, true>(lds, g, so, e); }
        { WSP pg8::Gemm g{(const bf16_t*)(ws + WS_OC), (const bf16_t*)(ws + W_C), S, 1024, 512}; pg8::StaticOrder so; so.init(S, 1024, G, bid); EpiGate e{(const bf16_t*)(ws + WS_GM), (float*)(ws + WS_M32), (bf16_t*)(ws + WS_MB), 2048, 2};
          pg8::gemm_phase<EpiGate, pg8::StaticOrder, true, true>(lds, g, so, e); }
        GRID_BAR();
        { WSP pg8::Gemm g{(const bf16_t*)(ws + WS_MB), (const bf16_t*)(ws + W_O), S, 1024, 1024}; pg8::StaticOrder so; so.init(S, 1024, G, bid); EpiRes e{ap->out, V32, 1.0f};
          pg8::gemm_phase<EpiRes, pg8::StaticOrder, true, true>(lds, g, so, e); }
        GRID_BAR();
        { WSP ln_phase(V32, ap->in[1] + (size_t)l * 3 * D + D, ap->in[2] + (size_t)l * 3 * D + D, ap->out, XB, tid, bid, G); }
        GRID_BAR();
        { WSP pg8::Gemm g{XB, (const bf16_t*)(ws + W_GU2), S, 5632, 1024}; pg8::StaticOrder so; so.init(S, 5632, G, bid); EpiFfn e{H};
          pg8::gemm_phase<EpiFfn, pg8::StaticOrder, true, true>(lds, g, so, e); }
        GRID_BAR();
        { WSP pg8::Gemm g{H, (const bf16_t*)(ws + W_D2), S, 1024, FF}; pg8::StaticOrder so; so.init(S, 1024, G, bid); EpiRes e{ap->out, V32, 0.5f};
          pg8::gemm_phase<EpiRes, pg8::StaticOrder, true, true>(lds, g, so, e); }
        GRID_BAR();
        { WSP ln_phase(V32, ap->in[1] + (size_t)l * 3 * D + 2 * D, ap->in[2] + (size_t)l * 3 * D + 2 * D, ap->out, XB, tid, bid, G); }
        GRID_BAR();
    }
    #undef WSP
    #undef GRID_BAR
}

extern "C" void kernel_launch(void* const* d_in, const int* in_sizes, int n_in, void* d_out, int out_size, void* d_ws, size_t ws_size, hipStream_t stream) {
    static int grid = 0;
    if (grid == 0) {
        if (n_in != 24 || in_sizes[0] != S * D || out_size != S * D || ws_size < WS_END) { fprintf(stderr, "kernel_launch: unexpected shapes (n_in %d, in0 %d, out %d, ws %zu)\n", n_in, n_in > 0 ? in_sizes[0] : -1, out_size, ws_size); grid = -1; return; }
        int dev = 0, cus = 0, per_cu = 0;
        hipGetDevice(&dev); hipDeviceGetAttribute(&cus, hipDeviceAttributeMultiprocessorCount, dev);
        if (hipFuncSetAttribute((const void*)fwd_kernel, hipFuncAttributeMaxDynamicSharedMemorySize, LDS_BYTES) != hipSuccess) { fprintf(stderr, "kernel_launch: hipFuncSetAttribute failed\n"); grid = -1; return; }
        if (hipOccupancyMaxActiveBlocksPerMultiprocessor(&per_cu, (const void*)fwd_kernel, NTHR, LDS_BYTES) != hipSuccess || per_cu < 1) { fprintf(stderr, "kernel_launch: occupancy query gave %d\n", per_cu); per_cu = 1; }
        (void)hipGetLastError();
        grid = cus;
    }
    if (grid < 0) return;
    Args a{};
    for (int i = 0; i < 24; ++i) a.in[i] = (const float*)d_in[i];
    a.out = (float*)d_out; a.ws = (unsigned char*)d_ws;
    for (int d = 0; d < 32; ++d) { const float p = (float)pow(10000.0, (double)d / 32.0); a.inv[d] = 1.0f / p; }
    if (hipMemsetAsync(d_ws, 0, 1u << 20, stream) != hipSuccess) { fprintf(stderr, "kernel_launch: hipMemsetAsync failed\n"); return; }
    void* args[] = {&a};
    hipError_t e = hipLaunchCooperativeKernel((const void*)fwd_kernel, dim3(grid), dim3(NTHR), args, LDS_BYTES, stream);
    if (e != hipSuccess) fprintf(stderr, "cooperative launch failed: %s (grid %d)\n", hipGetErrorString(e), grid);
}
```
